# Optimizing an MI355X kernel written in HIP

```python
import jax, jax.numpy as jnp
from jax import lax
import numpy as np

D_MODEL = 2048
BATCH = 4
SEQ = 4096
DEPTH = 2

EPS = 1e-6

N_ATT_HEADS = 8
ATT_HEAD_DIM = 128
Q_RANK = 512
KV_RANK = 256
N_IDX_HEADS = 8
IDX_DIM = 64
TOPK_MAX = 256
Q_BLOCK = 128

N_MLSTM_HEADS = 4
MLSTM_QK_DIM = 128
MLSTM_V_DIM = 256
MLSTM_CHUNK = 64
F_BIAS_INIT = 3.0

ATT_WIDTH = N_ATT_HEADS * ATT_HEAD_DIM
MLSTM_WIDTH = N_MLSTM_HEADS * MLSTM_V_DIM
MIX_WIDTH = ATT_WIDTH + MLSTM_WIDTH

IN_SPLITS = (Q_RANK, KV_RANK, IDX_DIM, N_IDX_HEADS,
             N_MLSTM_HEADS * MLSTM_QK_DIM, N_MLSTM_HEADS * MLSTM_QK_DIM,
             MLSTM_WIDTH, MLSTM_WIDTH, N_MLSTM_HEADS, N_MLSTM_HEADS)
D_IN = Q_RANK + KV_RANK + IDX_DIM + N_IDX_HEADS + 2 * N_MLSTM_HEADS * MLSTM_QK_DIM + 2 * MLSTM_WIDTH + 2 * N_MLSTM_HEADS

N_EXPERT_GROUPS = 4
EXPERTS_PER_GROUP = 8
N_EXPERTS = N_EXPERT_GROUPS * EXPERTS_PER_GROUP
TOP_K_EXPERTS = 2
D_FF_EXPERT = 512

kernel_name = "hybrid_dsa_mlstm_grouped_moe_adaln"


def rmsnorm(x, g):
    x32 = x.astype(jnp.float32)
    y = x32 * lax.rsqrt(jnp.mean(x32 * x32, axis=-1, keepdims=True) + EPS)
    return y.astype(x.dtype) * g


def dsa_attention(cq, ckv, k_idx, w_idx, w_uq, w_uk, w_uv, w_qidx):
    B, S, _ = cq.shape
    k_sel = min(TOPK_MAX, S // 4)
    nb = S // Q_BLOCK
    q = (cq @ w_uq).reshape(B, S, N_ATT_HEADS, ATT_HEAD_DIM)
    q_lat = jnp.einsum('bshd,rhd->bshr', q, w_uk)
    q_idx = (cq @ w_qidx).reshape(B, S, N_IDX_HEADS, IDX_DIM)
    w = w_idx * (N_IDX_HEADS ** -0.5 * IDX_DIM ** -0.5)
    scale = ATT_HEAD_DIM ** -0.5
    key_pos = jnp.arange(S)

    def to_blocks(a):
        return a.reshape(B, nb, Q_BLOCK, *a.shape[2:]).swapaxes(0, 1)

    def block(args):
        blk, ql, qi, wb = args
        t = blk * Q_BLOCK + jnp.arange(Q_BLOCK)
        isc = jax.nn.relu(jnp.einsum('bqhd,bsd->bqhs', qi, k_idx).astype(jnp.float32))
        isc = jnp.einsum('bqh,bqhs->bqs', wb.astype(jnp.float32), isc)
        causal = key_pos[None, :] <= t[:, None]
        isc = jnp.where(causal[None], isc, -jnp.inf)
        _, idx = lax.top_k(isc, k_sel)
        kv = jax.vmap(lambda c_b, i_b: c_b[i_b])(ckv, idx)
        s = jnp.einsum('bqhr,bqkr->bqhk', ql, kv).astype(jnp.float32) * scale
        valid = (idx <= t[None, :, None])[:, :, None, :]
        p = jax.nn.softmax(jnp.where(valid, s, -jnp.inf), axis=-1).astype(kv.dtype)
        o_lat = jnp.einsum('bqhk,bqkr->bqhr', p, kv)
        o = jnp.einsum('bqhr,rhd->bqhd', o_lat, w_uv)
        return o.reshape(B, Q_BLOCK, ATT_WIDTH)

    out = lax.map(block, (jnp.arange(nb), to_blocks(q_lat), to_blocks(q_idx), to_blocks(w)))
    return out.swapaxes(0, 1).reshape(B, S, ATT_WIDTH)


def mlstm(q, k, v, ig, fg):
    dtype = v.dtype
    B, S, NH, dk = q.shape
    dv = v.shape[-1]
    L = MLSTM_CHUNK
    nc = S // L

    def chunk4(a):
        return a.astype(jnp.float32).reshape(B, nc, L, NH, a.shape[-1]).transpose(1, 0, 3, 2, 4)

    def chunk3(a):
        return a.astype(jnp.float32).reshape(B, nc, L, NH).transpose(1, 0, 3, 2)

    qc = chunk4(q) * (dk ** -0.5)
    kc, vc = chunk4(k), chunk4(v)
    igc = chunk3(ig)
    lfc = jax.nn.log_sigmoid(chunk3(fg))
    causal = jnp.tril(jnp.ones((L, L), dtype=bool))

    def step(carry, xs):
        C, n, m = carry
        qb, kb, vb, ib, lf = xs
        b = lax.cumsum(lf, axis=2)
        dmat = b[..., :, None] - b[..., None, :] + ib[..., None, :]
        dmat = jnp.where(causal, dmat, -jnp.inf)
        m_inter = b + m[..., None]
        m_j = jnp.maximum(m_inter, dmat.max(-1))
        w_inter = jnp.exp(m_inter - m_j)
        sc = jnp.einsum('bhjd,bhsd->bhjs', qb, kb) * jnp.exp(dmat - m_j[..., None])
        num = w_inter[..., None] * jnp.einsum('bhjd,bhde->bhje', qb, C) + jnp.einsum('bhjs,bhse->bhje', sc, vb)
        den = w_inter * jnp.einsum('bhjd,bhd->bhj', qb, n) + sc.sum(-1)
        h = num / jnp.maximum(jnp.abs(den), jnp.exp(-m_j))[..., None]
        b_last = b[..., -1]
        g = b_last[..., None] - b + ib
        m_new = jnp.maximum(b_last + m, g.max(-1))
        w_old = jnp.exp(b_last + m - m_new)
        w_s = jnp.exp(g - m_new[..., None])
        C_new = w_old[..., None, None] * C + jnp.einsum('bhs,bhsd,bhse->bhde', w_s, kb, vb)
        n_new = w_old[..., None] * n + jnp.einsum('bhs,bhsd->bhd', w_s, kb)
        return (C_new, n_new, m_new), h

    init = (jnp.zeros((B, NH, dk, dv), jnp.float32),
            jnp.zeros((B, NH, dk), jnp.float32),
            jnp.zeros((B, NH), jnp.float32))
    _, h = lax.scan(step, init, (qc, kc, vc, igc, lfc))
    return h.transpose(1, 0, 3, 2, 4).reshape(B, S, NH, dv).astype(dtype)


def grouped_moe(h, router_w, router_b, w_gate_up, w_down):
    B, S, D = h.shape
    T = B * S
    xt = h.reshape(T, D)
    aff = jax.nn.sigmoid((xt @ router_w).astype(jnp.float32))
    sel = aff + router_b.astype(jnp.float32)
    grp = sel.reshape(T, N_EXPERT_GROUPS, EXPERTS_PER_GROUP)
    grp_score = lax.top_k(grp, TOP_K_EXPERTS)[0].sum(-1)
    g_idx = jnp.argmax(grp_score, axis=-1)
    in_grp = jnp.take_along_axis(grp, g_idx[:, None, None], axis=1)[:, 0]
    _, loc = lax.top_k(in_grp, TOP_K_EXPERTS)
    e_idx = g_idx[:, None] * EXPERTS_PER_GROUP + loc
    a = jnp.take_along_axis(aff, e_idx, axis=1)
    gates = a / a.sum(-1, keepdims=True)
    e_flat = e_idx.reshape(-1)
    tok = jnp.repeat(jnp.arange(T), TOP_K_EXPERTS)
    order = jnp.argsort(e_flat)
    tok_s = tok[order]
    gate_s = gates.reshape(-1)[order]
    group_sizes = jnp.bincount(e_flat, length=N_EXPERTS).astype(jnp.int32)
    xs = xt[tok_s]
    gu = lax.ragged_dot(xs, w_gate_up, group_sizes)
    gt, up = jnp.split(gu, 2, axis=-1)
    ys = lax.ragged_dot(jax.nn.silu(gt) * up, w_down, group_sizes) * gate_s[:, None].astype(xt.dtype)
    out = jnp.zeros_like(xt).at[tok_s].add(ys)
    return out.reshape(B, S, D)


def setup_inputs(seed: int = 0) -> dict:
    key = jax.random.key(seed)
    ks = jax.random.split(key, 24)

    def nrm(k, shape, scale):
        return jax.random.normal(k, shape, jnp.float32) * scale

    def gain(k, shape):
        return 1.0 + 0.01 * jax.random.normal(k, shape, jnp.float32)

    return {
        "x": nrm(ks[0], (BATCH, SEQ, D_MODEL), 1.0),
        "c": nrm(ks[1], (BATCH, D_MODEL), 1.0),
        "ada_w": nrm(ks[2], (DEPTH, D_MODEL, 6 * D_MODEL), 0.5 * D_MODEL ** -0.5),
        "ada_b": nrm(ks[3], (DEPTH, 6 * D_MODEL), 0.01),
        "mix_norm_g": gain(ks[4], (DEPTH, D_MODEL)),
        "w_in": nrm(ks[5], (DEPTH, D_MODEL, D_IN), D_MODEL ** -0.5),
        "cq_norm_g": gain(ks[6], (DEPTH, Q_RANK)),
        "ckv_norm_g": gain(ks[7], (DEPTH, KV_RANK)),
        "w_uq": nrm(ks[8], (DEPTH, Q_RANK, ATT_WIDTH), Q_RANK ** -0.5),
        "w_uk": nrm(ks[9], (DEPTH, KV_RANK, N_ATT_HEADS, ATT_HEAD_DIM), KV_RANK ** -0.5),
        "w_uv": nrm(ks[10], (DEPTH, KV_RANK, N_ATT_HEADS, ATT_HEAD_DIM), KV_RANK ** -0.5),
        "w_qidx": nrm(ks[11], (DEPTH, Q_RANK, N_IDX_HEADS * IDX_DIM), Q_RANK ** -0.5),
        "mlstm_i_b": nrm(ks[12], (DEPTH, N_MLSTM_HEADS), 0.1),
        "mlstm_f_b": F_BIAS_INIT + 3.0 * jax.random.uniform(ks[13], (DEPTH, N_MLSTM_HEADS), jnp.float32),
        "mlstm_norm_g": gain(ks[14], (DEPTH, N_MLSTM_HEADS, MLSTM_V_DIM)),
        "w_out": nrm(ks[15], (DEPTH, MIX_WIDTH, D_MODEL), MIX_WIDTH ** -0.5),
        "ffn_norm_g": gain(ks[16], (DEPTH, D_MODEL)),
        "router_w": nrm(ks[17], (D_MODEL, N_EXPERTS), D_MODEL ** -0.5),
        "router_b": nrm(ks[18], (N_EXPERTS,), 0.01),
        "w_gate_up": nrm(ks[19], (DEPTH, N_EXPERTS, D_MODEL, 2 * D_FF_EXPERT), D_MODEL ** -0.5),
        "w_down": nrm(ks[20], (DEPTH, N_EXPERTS, D_FF_EXPERT, D_MODEL), D_FF_EXPERT ** -0.5),
        "final_norm_g": gain(ks[21], (D_MODEL,)),
    }


def reference(x, c, ada_w, ada_b, mix_norm_g, w_in, cq_norm_g, ckv_norm_g, w_uq, w_uk, w_uv,
              w_qidx, mlstm_i_b, mlstm_f_b, mlstm_norm_g, w_out, ffn_norm_g, router_w, router_b,
              w_gate_up, w_down, final_norm_g):
    B, S, _ = x.shape
    NH = N_MLSTM_HEADS
    split_pts = np.cumsum(IN_SPLITS)[:-1].tolist()
    c_act = jax.nn.silu(c)
    for l in range(DEPTH):
        mod = (c_act @ ada_w[l] + ada_b[l])[:, None, :]
        sh1, sc1, g1, sh2, sc2, g2 = jnp.split(mod, 6, axis=-1)
        h = rmsnorm(x, mix_norm_g[l]) * (1 + sc1) + sh1
        z = h @ w_in[l]
        cq, ckv, k_idx, w_idx, mq, mk, mv, mo, mi, mf = jnp.split(z, split_pts, axis=-1)
        att = dsa_attention(rmsnorm(cq, cq_norm_g[l]), rmsnorm(ckv, ckv_norm_g[l]), k_idx, w_idx,
                            w_uq[l], w_uk[l], w_uv[l], w_qidx[l])
        hm = mlstm(mq.reshape(B, S, NH, MLSTM_QK_DIM), mk.reshape(B, S, NH, MLSTM_QK_DIM),
                   mv.reshape(B, S, NH, MLSTM_V_DIM), mi + mlstm_i_b[l], mf + mlstm_f_b[l])
        hm = rmsnorm(hm, mlstm_norm_g[l]).reshape(B, S, MLSTM_WIDTH) * jax.nn.sigmoid(mo)
        y = jnp.concatenate([att, hm], axis=-1) @ w_out[l]
        x = x + g1 * y
        h2 = rmsnorm(x, ffn_norm_g[l]) * (1 + sc2) + sh2
        x = x + g2 * grouped_moe(h2, router_w, router_b, w_gate_up[l], w_down[l])
    return rmsnorm(x, final_norm_g)
```

```cpp
#include <hip/hip_runtime.h>
#include <cstdio>
#include <cstdint>

#define LAS __attribute__((address_space(3)))
#define GAS __attribute__((address_space(1)))
typedef unsigned short bf16;
typedef short bf16x8 __attribute__((ext_vector_type(8)));
typedef float f32x4 __attribute__((ext_vector_type(4)));
typedef float f32x16 __attribute__((ext_vector_type(16)));
typedef unsigned v4u __attribute__((ext_vector_type(4)));
typedef unsigned v2u __attribute__((ext_vector_type(2)));
#define LDS_WAIT() asm volatile("s_waitcnt lgkmcnt(0)" ::: "memory")
#define VM_WAIT() asm volatile("s_waitcnt vmcnt(0)" ::: "memory")

__device__ __forceinline__ unsigned cvt_pk_bf16(float lo, float hi) { unsigned r; asm volatile("v_cvt_pk_bf16_f32 %0, %1, %2" : "=v"(r) : "v"(lo), "v"(hi)); return r; }
__device__ __forceinline__ float bf_lo(unsigned u) { return __builtin_bit_cast(float, u << 16); }
__device__ __forceinline__ float bf_hi(unsigned u) { return __builtin_bit_cast(float, u & 0xffff0000u); }
__device__ __forceinline__ float wave_sum(float v) {
#pragma unroll
    for (int o = 1; o < 64; o <<= 1) v += __shfl_xor(v, o);
    return v;
}

namespace pg8 {
typedef unsigned short bf16_t;
constexpr int BM = 256, BK = 64, HALF = 128, HTB = HALF * BK * 2, STAGE_BYTES = 8 * HTB, NXCD = 8, WGM = 8;
__host__ __device__ __forceinline__ int lds_byte(int r, int c) { const int st = (r >> 4) * 2 + (c >> 5), rr = r & 15, cc = c & 31, ob = rr * 64 + cc * 2; return st * 1024 + (ob ^ (((ob >> 9) & 1) << 5)); }
__host__ __device__ __forceinline__ void stage_rc(int b, int& R, int& C) { const int st = b / 1024, sb = b % 1024, swz = sb ^ (((sb >> 9) & 1) << 5); R = (st >> 1) * 16 + swz / 64; C = (st & 1) * 32 + (swz % 64) / 2; }
__host__ __device__ __forceinline__ int perm32(int rho) { const int n = rho >> 4, i = rho & 15; return 8 * (i >> 2) + 4 * n + (i & 3); }
struct Unit { int pm, pn; };
struct Gemm { const bf16_t* A; const bf16_t* Bt; int M, N, K; };
struct StaticOrder {
    int nM, nN, nwg, G, c;
    __host__ __device__ void init(int M, int N, int G_, int c_) { nM = M / BM; nN = N / BM; nwg = nM * nN; G = G_; c = c_; }
    __host__ __device__ bool next(int i, Unit& u) const {
        const long L = (long)i * G + c; if (L >= nwg) return false;
        int wgid = (int)L; { const int q = nwg / NXCD, r = nwg % NXCD, xcd = wgid % NXCD, off = wgid / NXCD; wgid = (xcd < r ? xcd * (q + 1) : r * (q + 1) + (xcd - r) * q) + off; }
        const int nig = WGM * nN, gid = wgid / nig, fm = gid * WGM, gsz = (nM - fm) < WGM ? (nM - fm) : WGM;
        u.pm = fm + ((wgid % nig) % gsz); u.pn = (wgid % nig) / gsz; return true;
    }
    __device__ __forceinline__ void a_ready(const Unit&) const {}
    __device__ __forceinline__ void done(const Unit&) const {}
};
template <class Epi, class Sched, bool ALIGN_EPI = false, bool SP2 = false>
__device__ __forceinline__ void gemm_phase(LAS unsigned char* lds, const Gemm g, const Sched& S, const Epi& E) {
    const int tid = threadIdx.x, wid = __builtin_amdgcn_readfirstlane(tid >> 6), lane = tid & 63, wr = wid >> 2, wc = wid & 3, fr = lane & 15, fq = lane >> 4;
    const int K = g.K, nt = K / BK;
    unsigned voffA[2], voffB[2];
#pragma unroll
    for (int i = 0; i < 2; ++i) { int R, C; stage_rc(tid * 16 + i * 8192, R, C); const int Rb = Epi::PERM ? ((R & ~31) + perm32(R & 31)) : R;
        voffA[i] = (unsigned)(R * K + C) * 2u; voffB[i] = (unsigned)(Rb * K + C) * 2u; }
    const size_t kstep = (size_t)(BK * 2);
    const size_t hstep = (size_t)HALF * K * 2;
    const size_t tstep = 2 * hstep;
    const unsigned ldsw = (unsigned)wid * 1024u;
    const int aoff = lds_byte(wr * 64 + fr, fq * 8), boff = lds_byte(wc * 32 + fr, fq * 8);
#define PG8_SA(b, h) (((b) * 2 + (h)) * HTB)
#define PG8_SB(b, h) ((4 + (b) * 2 + (h)) * HTB)
#define PG8_STAGE(bufoff, gbase, voff) do { _Pragma("unroll") for (int _i = 0; _i < 2; ++_i) \
        __builtin_amdgcn_global_load_lds((const unsigned*)((const char*)(gbase) + (voff)[_i]), (LAS unsigned*)(lds + (bufoff) + ldsw + _i * 8192), 16, 0, 0); } while (0)
#define PG8_LDA(dst, b, h) do { _Pragma("unroll") for (int m = 0; m < 4; ++m) _Pragma("unroll") for (int k = 0; k < 2; ++k) dst[m][k] = *(const LAS bf16x8*)(lds + PG8_SA(b, h) + aoff + m * 2048 + k * 1024); } while (0)
#define PG8_LDB(dst, b, h) do { _Pragma("unroll") for (int n = 0; n < 2; ++n) _Pragma("unroll") for (int k = 0; k < 2; ++k) dst[n][k] = *(const LAS bf16x8*)(lds + PG8_SB(b, h) + boff + n * 2048 + k * 1024); } while (0)
#define PG8_MMA(ai, bj, At, Bt) do { __builtin_amdgcn_s_setprio(1); _Pragma("unroll") for (int m = 0; m < 4; ++m) _Pragma("unroll") for (int n = 0; n < 2; ++n) _Pragma("unroll") for (int k = 0; k < 2; ++k) \
        acc[ai][bj][m][n] = __builtin_amdgcn_mfma_f32_16x16x32_bf16(Bt[n][k], At[m][k], acc[ai][bj][m][n], 0, 0, 0); __builtin_amdgcn_s_setprio(0); } while (0)
#define PG8_WAIT_V(n) asm volatile("s_waitcnt vmcnt(" #n ")" ::: "memory")
#define PG8_WAIT_L(n) asm volatile("s_waitcnt lgkmcnt(" #n ")" ::: "memory")
#define PG8_BAR __builtin_amdgcn_s_barrier()
#define PG8_SCHED __builtin_amdgcn_sched_barrier(0)
    Unit cur, nxt; int ui = 0;
    if (!S.next(0, cur)) return;
    f32x4 acc[2][2][4][2];
#pragma unroll
    for (int a = 0; a < 2; ++a)
#pragma unroll
        for (int b = 0; b < 2; ++b)
#pragma unroll
            for (int m = 0; m < 4; ++m)
#pragma unroll
                for (int n = 0; n < 2; ++n) acc[a][b][m][n] = (f32x4){0.f, 0.f, 0.f, 0.f};
    bf16x8 At[4][2], B0[2][2], B1[2][2];
    const char* cA = (const char*)g.A + (size_t)cur.pm * tstep; const char* cB = (const char*)g.Bt + (size_t)cur.pn * tstep;
    S.a_ready(cur);
    if constexpr (SP2) {
        PG8_STAGE(PG8_SB(0, 0), cB, voffB); PG8_STAGE(PG8_SB(0, 1), cB + hstep, voffB); PG8_STAGE(PG8_SA(0, 0), cA, voffA); PG8_STAGE(PG8_SA(0, 1), cA + hstep, voffA);
        if (wr == 1) PG8_BAR;
        PG8_WAIT_V(2); PG8_BAR;
        PG8_STAGE(PG8_SB(1, 0), cB + kstep, voffB); PG8_STAGE(PG8_SA(1, 0), cA + kstep, voffA); PG8_STAGE(PG8_SB(1, 1), cB + hstep + kstep, voffB);
        PG8_WAIT_V(6); PG8_BAR;
    } else {
        PG8_STAGE(PG8_SB(0, 0), cB, voffB); PG8_STAGE(PG8_SA(0, 0), cA, voffA); PG8_STAGE(PG8_SB(0, 1), cB + hstep, voffB); PG8_STAGE(PG8_SA(0, 1), cA + hstep, voffA);
        if (wr == 1) PG8_BAR;
        PG8_WAIT_V(4); PG8_BAR;
        PG8_STAGE(PG8_SB(1, 0), cB + kstep, voffB); PG8_STAGE(PG8_SA(1, 0), cA + kstep, voffA); PG8_STAGE(PG8_SB(1, 1), cB + hstep + kstep, voffB);
        PG8_WAIT_V(6); PG8_BAR;
    }
    for (;;) {
        const bool has_next = S.next(ui + 1, nxt);
        const char* nA = has_next ? (const char*)g.A + (size_t)nxt.pm * tstep : cA; const char* nB = has_next ? (const char*)g.Bt + (size_t)nxt.pn * tstep : cB;
        for (int t = 0; t < nt; t += 2) {
            const bool last = (t == nt - 2);
            const char* a1 = cA + (size_t)(t + 1) * kstep;
            const char* a2 = last ? nA : cA + (size_t)(t + 2) * kstep; const char* b2 = last ? nB : cB + (size_t)(t + 2) * kstep;
            const char* a3 = a2 + kstep; const char* b3 = b2 + kstep;
            if (last && has_next) S.a_ready(nxt);
            if constexpr (SP2) {
            PG8_LDB(B0, 0, 0); PG8_LDB(B1, 0, 1); PG8_SCHED; PG8_LDA(At, 0, 0); PG8_STAGE(PG8_SA(1, 1), a1 + hstep, voffA);
            PG8_WAIT_V(8); PG8_WAIT_L(0); PG8_BAR; PG8_MMA(0, 0, At, B0); PG8_MMA(0, 1, At, B1); PG8_BAR; PG8_SCHED;
            PG8_LDA(At, 0, 1); PG8_STAGE(PG8_SB(0, 0), b2, voffB); PG8_STAGE(PG8_SB(0, 1), b2 + hstep, voffB); PG8_STAGE(PG8_SA(0, 0), a2, voffA);
            PG8_WAIT_V(8); PG8_WAIT_L(0); PG8_BAR; PG8_MMA(1, 0, At, B0); PG8_MMA(1, 1, At, B1); PG8_BAR; PG8_SCHED;
            PG8_LDB(B0, 1, 0); PG8_LDB(B1, 1, 1); PG8_SCHED; PG8_LDA(At, 1, 0); PG8_STAGE(PG8_SA(0, 1), a2 + hstep, voffA);
            PG8_WAIT_V(8); PG8_WAIT_L(0); PG8_BAR; PG8_MMA(0, 0, At, B0); PG8_MMA(0, 1, At, B1); PG8_BAR; PG8_SCHED;
            PG8_LDA(At, 1, 1); PG8_STAGE(PG8_SB(1, 0), b3, voffB); PG8_STAGE(PG8_SB(1, 1), b3 + hstep, voffB); PG8_STAGE(PG8_SA(1, 0), a3, voffA);
            PG8_WAIT_V(8); PG8_WAIT_L(0); PG8_BAR; PG8_MMA(1, 0, At, B0); PG8_MMA(1, 1, At, B1); PG8_BAR; PG8_SCHED;
            } else {
            PG8_LDB(B0, 0, 0); PG8_SCHED; PG8_LDA(At, 0, 0); PG8_STAGE(PG8_SA(1, 1), a1 + hstep, voffA);
            PG8_WAIT_L(8); PG8_BAR; PG8_WAIT_L(0); PG8_MMA(0, 0, At, B0); PG8_BAR; PG8_SCHED;
            PG8_LDB(B1, 0, 1); PG8_STAGE(PG8_SB(0, 0), b2, voffB);
            PG8_BAR; PG8_WAIT_L(0); PG8_MMA(0, 1, At, B1); PG8_BAR;
            PG8_LDA(At, 0, 1); PG8_STAGE(PG8_SA(0, 0), a2, voffA);
            PG8_BAR; PG8_WAIT_L(0); PG8_MMA(1, 0, At, B0); PG8_BAR; PG8_SCHED;
            PG8_STAGE(PG8_SB(0, 1), b2 + hstep, voffB);
            PG8_WAIT_V(6); PG8_BAR; PG8_MMA(1, 1, At, B1); PG8_BAR;
            PG8_LDB(B0, 1, 0); PG8_SCHED; PG8_LDA(At, 1, 0); PG8_STAGE(PG8_SA(0, 1), a2 + hstep, voffA);
            PG8_WAIT_L(8); PG8_BAR; PG8_WAIT_L(0); PG8_MMA(0, 0, At, B0); PG8_BAR; PG8_SCHED;
            PG8_LDB(B1, 1, 1); PG8_STAGE(PG8_SB(1, 0), b3, voffB);
            PG8_BAR; PG8_WAIT_L(0); PG8_MMA(0, 1, At, B1); PG8_BAR;
            PG8_LDA(At, 1, 1); PG8_STAGE(PG8_SA(1, 0), a3, voffA);
            PG8_BAR; PG8_WAIT_L(0); PG8_MMA(1, 0, At, B0); PG8_BAR; PG8_SCHED;
            PG8_STAGE(PG8_SB(1, 1), b3 + hstep, voffB);
            PG8_WAIT_V(6); PG8_BAR; PG8_MMA(1, 1, At, B1); PG8_BAR;
            }
        }
        if constexpr (ALIGN_EPI) { if (wr == 0) PG8_BAR; }
        E(acc, cur, wr, wc, fr, fq); S.done(cur);
        if (!has_next) break;
#pragma unroll
        for (int a = 0; a < 2; ++a)
#pragma unroll
            for (int b = 0; b < 2; ++b)
#pragma unroll
                for (int m = 0; m < 4; ++m)
#pragma unroll
                    for (int n = 0; n < 2; ++n) acc[a][b][m][n] = (f32x4){0.f, 0.f, 0.f, 0.f};
        cur = nxt; cA = nA; cB = nB; ++ui;
        if constexpr (ALIGN_EPI) { if (wr == 1) PG8_BAR; }
    }
    PG8_WAIT_V(0);
    if constexpr (!ALIGN_EPI) { if (wr == 0) PG8_BAR; }
    PG8_BAR;
#undef PG8_SA
#undef PG8_SB
#undef PG8_STAGE
#undef PG8_LDA
#undef PG8_LDB
#undef PG8_MMA
#undef PG8_WAIT_V
#undef PG8_WAIT_L
#undef PG8_BAR
#undef PG8_SCHED
}
}

#define XB_TMO      128
#define XB_XCNT(j)  (256  + 64 * (j))
#define XB_XSUB(j)  (1280 + 64 * (j))
#define XB_XGEN(j)  (2304 + 64 * (j))
#define XB_TOP      3328
#define XB_TOPGEN   3392
#define XCD_BAR_WORDS 3456
#define XB_SPIN_CAP (1u << 18)
__device__ __forceinline__ unsigned xb_ld(unsigned* p)              { return __hip_atomic_load(p, __ATOMIC_RELAXED, __HIP_MEMORY_SCOPE_AGENT); }
__device__ __forceinline__ unsigned xb_add(unsigned* p, unsigned v) { return __hip_atomic_fetch_add(p, v, __ATOMIC_RELAXED, __HIP_MEMORY_SCOPE_AGENT); }
__device__ __forceinline__ unsigned xb_xcc_id() { return (unsigned)__builtin_amdgcn_s_getreg((3 << 11) | 20) & 0xFu; }
#define XB_SPIN(cond, bar) do { unsigned _sp = 0; while (cond) { __builtin_amdgcn_s_sleep(1); \
    if ((++_sp & 255u) == 0u) { if (xb_ld(&(bar)[XB_TMO])) break; if (_sp > XB_SPIN_CAP) { atomicAdd(&(bar)[XB_TMO], 1u); break; } } } } while (0)
struct XcdBarrier { unsigned* bar; unsigned x; volatile LAS unsigned* st; };
__device__ __forceinline__ XcdBarrier xcd_barrier_post(unsigned* bar, volatile LAS unsigned* st) {
    XcdBarrier b; b.bar = bar; b.x = xb_xcc_id(); b.st = st;
    if (threadIdx.x == 0) (void)xb_add(&bar[XB_XCNT(b.x)], 1u);
    return b;
}
__device__ __forceinline__ void xcd_barrier_complete(unsigned* bar, unsigned x, unsigned& nloc, unsigned& nx) {
    const unsigned G = gridDim.x * gridDim.y * gridDim.z;
    unsigned sum, cnt, mine, sp = 0u;
    for (;;) {
        sum = 0u; cnt = 0u; mine = 0u;
#pragma unroll
        for (unsigned j = 0; j < 16; ++j) { const unsigned c = xb_ld(&bar[XB_XCNT(j)]); sum += c; cnt += (c > 0u) ? 1u : 0u; mine = (j == x) ? c : mine; }
        if (sum == G) break;
        __builtin_amdgcn_s_sleep(1);
        if ((++sp & 255u) == 0u) { if (xb_ld(&bar[XB_TMO])) break; if (sp > XB_SPIN_CAP) { atomicAdd(&bar[XB_TMO], 1u); break; } }
    }
    nloc = mine > 0u ? mine : 1u; nx = cnt > 0u ? cnt : 1u;
}
__device__ __forceinline__ void xcd_barrier(const XcdBarrier& b) {
    asm volatile("s_waitcnt vmcnt(0)" ::: "memory");
    __syncthreads();
    if (threadIdx.x == 0) {
        unsigned* bar = b.bar;
        __builtin_amdgcn_s_waitcnt(0);
        unsigned nloc = b.st[0], nx = b.st[1];
        if (nloc == 0u) { xcd_barrier_complete(bar, b.x, nloc, nx); b.st[0] = nloc; b.st[1] = nx; }
        const unsigned old = xb_add(&bar[XB_XSUB(b.x)], 1u);
        const unsigned gen = old / nloc;
        if (old + 1u == (gen + 1u) * nloc) {
            __builtin_amdgcn_fence(__ATOMIC_RELEASE, "agent");
            asm volatile("s_waitcnt vmcnt(0)" ::: "memory");
            const unsigned og = xb_add(&bar[XB_TOP], 1u);
            const unsigned tg = og / nx;
            if (og + 1u == (tg + 1u) * nx) xb_add(&bar[XB_TOPGEN], 1u);
            else XB_SPIN(xb_ld(&bar[XB_TOPGEN]) == tg, bar);
            __builtin_amdgcn_fence(__ATOMIC_ACQUIRE, "agent");
            xb_add(&bar[XB_XGEN(b.x)], 1u);
            asm volatile("s_waitcnt vmcnt(0)" ::: "memory");
        } else {
            XB_SPIN(xb_ld(&bar[XB_XGEN(b.x)]) == gen, bar);
            __builtin_amdgcn_fence(__ATOMIC_ACQUIRE, "agent");
            asm volatile("s_waitcnt vmcnt(0)" ::: "memory");
        }
    }
    __syncthreads();
}

constexpr int T = 16384, SEQ = 4096, NB = 4, D = 2048, DIN = 3920, NZ = 4096;
constexpr int NE = 32;
constexpr int MPAD = 40960;
constexpr float EPS = 1e-6f;
constexpr int NWAVES = 8, NTHR = 512;
constexpr size_t MiB = 1u << 20;
constexpr size_t WS_CTL = 0, CTL_ZERO_BYTES = 1 * MiB;
constexpr int CW_BAR = 4096;
constexpr int CW_ECNT = 8192;
constexpr size_t WS_MOD = 512 * 1024;
constexpr size_t WS_WIN = 2 * MiB, WS_WQ = 34 * MiB, WS_WOUT = 40 * MiB, WS_WR = 64 * MiB, WS_WGU = 66 * MiB, WS_WD = 322 * MiB;
constexpr size_t WS_H = 450 * MiB, WS_ZF = 514 * MiB, WS_ZB = 578 * MiB, WS_CQN = 674 * MiB, WS_CKVN = 690 * MiB, WS_KIDX = 698 * MiB;
constexpr size_t WS_QLAT = 700 * MiB, WS_QIDX = 764 * MiB, WS_AO = 780 * MiB, WS_X1 = 876 * MiB, WS_X2 = 1004 * MiB;
constexpr size_t WS_GATE = 1132 * MiB, WS_CT = 1134 * MiB, WS_NS = 1198 * MiB, WS_XS = 1200 * MiB, WS_ACT = 1360 * MiB, WS_YS = 1400 * MiB, WS_RT = 1560 * MiB, WS_END = 1564 * MiB;
constexpr size_t GATE_GA = 0, GATE_GMX = 262144, GATE_GB = 524288, GATE_MINS = 786432;
constexpr size_t RT_EIDX = 0, RT_GATE = 131072, RT_RANK = 262144, RT_TOKPOS = 393216, RT_ROWGATE = 524288, RT_TILEE = 524288 + 163840, RT_NT = RT_TILEE + 1024;
constexpr int LDS_BYTES = 147456;
constexpr int MISC_OFF = 140 * 1024;

struct Args { const float* in[22]; float* out; unsigned char* ws; int ph_lo, ph_hi; };

struct Frame {
    LAS unsigned char* lds;
    int tid, lane, wave, G;
    unsigned char* ws;
};

__device__ __forceinline__ int rowmap_win(int n) {
    if (n < 768) return n;
    if (n < 832) return 3840 + (n - 768);
    if (n < 840) return 3904 + (n - 832);
    if (n < 3912) return 768 + (n - 840);
    return 3912 + (n - 3912);
}
__device__ __forceinline__ int rowmap_gu(int n) { return n < 512 ? ((n >> 7) * 256 + (n & 127)) : (((n - 512) >> 7) * 256 + 128 + ((n - 512) & 127)); }

template <int RM>
__device__ __forceinline__ void tr_item(const float* __restrict__ W, int ldw, int nmax, int k0, int n0, bf16* WT, int ldt, int kdst0, LAS float* scr, int lane) {
    const int nn = lane & 31; const bool okn = (n0 + nn) < nmax;
#pragma unroll 8
    for (int i = 0; i < 32; ++i) { const int kk = 2 * i + (lane >> 5); scr[kk * 33 + nn] = okn ? W[(size_t)(k0 + kk) * ldw + n0 + nn] : 0.f; }
    LDS_WAIT(); asm volatile("" ::: "memory");
    const int c = lane & 7;
#pragma unroll
    for (int j = 0; j < 4; ++j) { const int n = (lane >> 3) + 8 * j; const LAS float* s = scr + (8 * c) * 33 + n;
        v4u o; o.x = cvt_pk_bf16(s[0 * 33], s[1 * 33]); o.y = cvt_pk_bf16(s[2 * 33], s[3 * 33]); o.z = cvt_pk_bf16(s[4 * 33], s[5 * 33]); o.w = cvt_pk_bf16(s[6 * 33], s[7 * 33]);
        const int ng = n0 + n; const int row = RM == 1 ? rowmap_win(ng) : (RM == 2 ? rowmap_gu(ng) : ng);
        if (ng < nmax) *(v4u*)(WT + (size_t)row * ldt + kdst0 + k0 + 8 * c) = o; }
    LDS_WAIT(); asm volatile("" ::: "memory");
}

template <bool QT>
__device__ __forceinline__ void fold_item(const float* __restrict__ P, int ps, const float* __restrict__ Q, int qs, bf16* dst, int ldd, float scale, LAS float* Ps, LAS float* Qs, int tid) {
    __syncthreads();
#pragma unroll 4
    for (int it = 0; it < 16; ++it) { const int idx = it * 512 + tid; const int r = idx >> 7, d = idx & 127; Ps[r * 129 + d] = P[(size_t)r * ps + d]; }
    if (!QT) {
#pragma unroll 4
        for (int it = 0; it < 16; ++it) { const int idx = it * 512 + tid; const int r = idx >> 7, d = idx & 127; Qs[r * 129 + d] = Q[(size_t)r * qs + d]; }
    } else {
#pragma unroll 4
        for (int it = 0; it < 16; ++it) { const int idx = it * 512 + tid; const int d = idx >> 6, j = idx & 63; Qs[j * 129 + d] = Q[(size_t)d * qs + j]; }
    }
    __syncthreads();
    const int i = tid & 63, j0 = (tid >> 6) * 8;
    float a[8];
#pragma unroll
    for (int jj = 0; jj < 8; ++jj) a[jj] = 0.f;
#pragma unroll 4
    for (int d = 0; d < 128; ++d) { const float p = Ps[i * 129 + d];
#pragma unroll
        for (int jj = 0; jj < 8; ++jj) a[jj] += p * Qs[(j0 + jj) * 129 + d]; }
#pragma unroll
    for (int jj = 0; jj < 8; ++jj) { const unsigned u = cvt_pk_bf16(a[jj] * scale, 0.f); dst[(size_t)(j0 + jj) * ldd + i] = (bf16)(u & 0xffffu); }
}

__device__ __forceinline__ void p0_prologue(Frame& F, const Args& A) {
    const float* c = A.in[1]; const float* ada_w = A.in[2]; const float* ada_b = A.in[3];
    const float* w_in = A.in[5]; const float* w_uq = A.in[8]; const float* w_uk = A.in[9]; const float* w_uv = A.in[10]; const float* w_qidx = A.in[11];
    const float* w_out = A.in[15]; const float* router_w = A.in[17]; const float* w_gu = A.in[19]; const float* w_dn = A.in[20];
    bf16* WIN = (bf16*)(F.ws + WS_WIN); bf16* WQ = (bf16*)(F.ws + WS_WQ); bf16* WOUT = (bf16*)(F.ws + WS_WOUT); bf16* WR = (bf16*)(F.ws + WS_WR);
    bf16* WGU = (bf16*)(F.ws + WS_WGU); bf16* WD = (bf16*)(F.ws + WS_WD); float* MOD = (float*)(F.ws + WS_MOD);
    const int gw = blockIdx.x * NWAVES + F.wave, NGW = F.G * NWAVES;
    {
        LAS float* cs = (LAS float*)(F.lds);
        for (int i = F.tid; i < NB * D; i += NTHR) { const float v = c[i]; cs[i] = v / (1.f + __expf(-v)); }
        __syncthreads();
        constexpr int NCG = 12288 / 128, NTASK = 2 * NCG;
        typedef float f32x2 __attribute__((ext_vector_type(2)));
        LAS float* red = (LAS float*)(F.lds + 32768);
        for (int task = blockIdx.x; task < NTASK; task += F.G) {
            const int cg = task % NCG, l = task / NCG;
            const int n = cg * 128 + F.lane * 2, k0 = F.wave * 256;
            const float* wp = ada_w + ((size_t)l * D + k0) * 12288 + n;
            f32x2 acc[4];
#pragma unroll
            for (int b = 0; b < 4; ++b) acc[b] = (f32x2){0.f, 0.f};
#pragma unroll 8
            for (int k = 0; k < 256; ++k) { const f32x2 w = *(const f32x2*)(wp + (size_t)k * 12288);
#pragma unroll
                for (int b = 0; b < 4; ++b) acc[b] += w * cs[b * D + k0 + k]; }
            __syncthreads();
#pragma unroll
            for (int b = 0; b < 4; ++b) { red[(F.wave * 4 + b) * 128 + F.lane * 2] = acc[b].x; red[(F.wave * 4 + b) * 128 + F.lane * 2 + 1] = acc[b].y; }
            __syncthreads();
            { const int b = F.tid >> 7, c = F.tid & 127; float sum = ada_b[(size_t)l * 12288 + cg * 128 + c];
#pragma unroll
              for (int w8 = 0; w8 < 8; ++w8) sum += red[(w8 * 4 + b) * 128 + c];
              MOD[((size_t)l * 4 + b) * 12288 + cg * 128 + c] = sum; }
        }
        __syncthreads();
    }
    {
        LAS float* Ps = (LAS float*)(F.lds); LAS float* Qs = Ps + 64 * 129;
        constexpr int NQL = 2 * 8 * 8 * 4, NOV = 2 * 8 * 4 * 32;
        for (int it = blockIdx.x; it < NQL + NOV; it += F.G) {
            if (it < NQL) { const int jt = it & 3, itl = (it >> 2) & 7, h = (it >> 5) & 7, l = it >> 8;
                fold_item<false>(w_uq + (size_t)l * 512 * 1024 + (size_t)(itl * 64) * 1024 + h * 128, 1024, w_uk + (size_t)l * 256 * 1024 + (size_t)(jt * 64) * 1024 + h * 128, 1024,
                                 WQ + (size_t)l * 2560 * 512 + (size_t)(h * 256 + jt * 64) * 512 + itl * 64, 512, 0.08838834764831845f * 1.4426950408889634f, Ps, Qs, F.tid);
            } else { const int r = it - NQL; const int jt = r & 31, itl = (r >> 5) & 3, h = (r >> 7) & 7, l = r >> 10;
                fold_item<true>(w_uv + (size_t)l * 256 * 1024 + (size_t)(itl * 64) * 1024 + h * 128, 1024, w_out + (size_t)l * 2048 * 2048 + (size_t)(h * 128) * 2048 + jt * 64, 2048,
                                WOUT + (size_t)l * 2048 * 3072 + (size_t)(jt * 64) * 3072 + h * 256 + itl * 64, 3072, 1.0f, Ps, Qs, F.tid);
            }
        }
        __syncthreads();
    }
    {
        LAS float* scr = (LAS float*)(F.lds + F.wave * 8704);
        constexpr int I_WIN = 32 * 123, I_QI = 8 * 16, I_WO = 16 * 64, I_R = 32 * 1, I_GU = 32 * 32, I_DN = 8 * 64;
        constexpr int NIT = 2 * I_WIN + 2 * I_QI + 2 * I_WO + I_R + 64 * I_GU + 64 * I_DN;
        for (int it = gw; it < NIT; it += NGW) {
            int r = it;
            if (r < 2 * I_WIN) { const int l = r / I_WIN; r %= I_WIN; const int kb = r / 123, nb = r % 123;
                tr_item<1>(w_in + (size_t)l * D * DIN, DIN, DIN, kb * 64, nb * 32, WIN + (size_t)l * NZ * D, D, 0, scr, F.lane); continue; } r -= 2 * I_WIN;
            if (r < 2 * I_QI) { const int l = r / I_QI; r %= I_QI; const int kb = r / 16, nb = r % 16;
                tr_item<0>(w_qidx + (size_t)l * 512 * 512, 512, 512, kb * 64, nb * 32, WQ + (size_t)l * 2560 * 512 + (size_t)2048 * 512, 512, 0, scr, F.lane); continue; } r -= 2 * I_QI;
            if (r < 2 * I_WO) { const int l = r / I_WO; r %= I_WO; const int kb = r / 64, nb = r % 64;
                tr_item<0>(w_out + (size_t)l * 2048 * 2048 + (size_t)1024 * 2048, 2048, 2048, kb * 64, nb * 32, WOUT + (size_t)l * 2048 * 3072, 3072, 2048, scr, F.lane); continue; } r -= 2 * I_WO;
            if (r < I_R) { tr_item<0>(router_w, 32, 32, r * 64, 0, WR, 2048, 0, scr, F.lane); continue; } r -= I_R;
            if (r < 64 * I_GU) { const int le = r / I_GU; r %= I_GU; const int kb = r / 32, nb = r % 32;
                tr_item<2>(w_gu + (size_t)le * 2048 * 1024, 1024, 1024, kb * 64, nb * 32, WGU + (size_t)le * 1024 * 2048, 2048, 0, scr, F.lane); continue; } r -= 64 * I_GU;
            { const int le = r / I_DN; r %= I_DN; const int kb = r / 64, nb = r % 64;
                tr_item<0>(w_dn + (size_t)le * 512 * 2048, 2048, 2048, kb * 64, nb * 32, WD + (size_t)le * 2048 * 512, 512, 0, scr, F.lane); }
        }
    }
}

__device__ __forceinline__ void norm_phase(Frame& F, const float* __restrict__ xin, const float* __restrict__ gain, const float* __restrict__ sc, const float* __restrict__ sh, bf16* H) {
    const int gw = blockIdx.x * NWAVES + F.wave, NGW = F.G * NWAVES;
    for (int rb = gw; rb < T / 8; rb += NGW) {
        const int r0 = rb * 8, b = r0 / SEQ;
        f32x4 ga[8], be[8];
#pragma unroll
        for (int j = 0; j < 8; ++j) { const int col = 4 * F.lane + 256 * j; const f32x4 g = *(const f32x4*)(gain + col), s = *(const f32x4*)(sc + (size_t)b * 12288 + col);
            ga[j] = g * (s + 1.0f); be[j] = *(const f32x4*)(sh + (size_t)b * 12288 + col); }
        for (int r = r0; r < r0 + 8; ++r) {
            const f32x4* xr = (const f32x4*)(xin + (size_t)r * D) + F.lane;
            f32x4 v[8]; float s = 0.f;
#pragma unroll
            for (int j = 0; j < 8; ++j) { v[j] = xr[64 * j]; s += (v[j].x * v[j].x + v[j].y * v[j].y) + (v[j].z * v[j].z + v[j].w * v[j].w); }
            const float rstd = 1.0f / sqrtf(wave_sum(s) * (1.f / D) + EPS);
            v2u* o = (v2u*)(H + (size_t)r * D) + F.lane;
#pragma unroll
            for (int j = 0; j < 8; ++j) { const f32x4 y = v[j] * rstd * ga[j] + be[j]; v2u w; w.x = cvt_pk_bf16(y.x, y.y); w.y = cvt_pk_bf16(y.z, y.w); o[64 * j] = w; }
        }
    }
}
__device__ __forceinline__ void combine_phase(Frame& F, int l, const float* __restrict__ X1, const float* __restrict__ g2, const bf16* __restrict__ YS, const int* __restrict__ tokpos,
                                              float* X2, const float* __restrict__ gain, const float* __restrict__ sc, const float* __restrict__ sh, bf16* H, float* out) {
    const int gw = blockIdx.x * NWAVES + F.wave, NGW = F.G * NWAVES;
    for (int rb = gw; rb < T / 8; rb += NGW) {
        const int r0 = rb * 8, b = r0 / SEQ;
        for (int r = r0; r < r0 + 8; ++r) {
            const int p0 = tokpos[2 * r], p1 = tokpos[2 * r + 1];
            const f32x4* xr = (const f32x4*)(X1 + (size_t)r * D) + F.lane;
            const v2u* y0 = (const v2u*)(YS + (size_t)p0 * D) + F.lane; const v2u* y1 = (const v2u*)(YS + (size_t)p1 * D) + F.lane;
            f32x4 v[8]; float s = 0.f;
#pragma unroll
            for (int j = 0; j < 8; ++j) { const int col = 4 * F.lane + 256 * j; const f32x4 g = *(const f32x4*)(g2 + (size_t)b * 12288 + col);
                const v2u a = y0[64 * j], c = y1[64 * j];
                f32x4 ys; ys.x = bf_lo(a.x) + bf_lo(c.x); ys.y = bf_hi(a.x) + bf_hi(c.x); ys.z = bf_lo(a.y) + bf_lo(c.y); ys.w = bf_hi(a.y) + bf_hi(c.y);
                v[j] = xr[64 * j] + g * ys; s += (v[j].x * v[j].x + v[j].y * v[j].y) + (v[j].z * v[j].z + v[j].w * v[j].w); }
            const float rstd = 1.0f / sqrtf(wave_sum(s) * (1.f / D) + EPS);
            if (l == 0) {
                f32x4* xo = (f32x4*)(X2 + (size_t)r * D) + F.lane; v2u* o = (v2u*)(H + (size_t)r * D) + F.lane;
#pragma unroll
                for (int j = 0; j < 8; ++j) { const int col = 4 * F.lane + 256 * j; xo[64 * j] = v[j];
                    const f32x4 g = *(const f32x4*)(gain + col), s1 = *(const f32x4*)(sc + (size_t)b * 12288 + col), h1 = *(const f32x4*)(sh + (size_t)b * 12288 + col);
                    const f32x4 y = v[j] * rstd * g * (s1 + 1.0f) + h1; v2u w; w.x = cvt_pk_bf16(y.x, y.y); w.y = cvt_pk_bf16(y.z, y.w); o[64 * j] = w; }
            } else {
                f32x4* oo = (f32x4*)(out + (size_t)r * D) + F.lane;
#pragma unroll
                for (int j = 0; j < 8; ++j) { const int col = 4 * F.lane + 256 * j; const f32x4 g = *(const f32x4*)(gain + col); oo[64 * j] = v[j] * rstd * g; }
            }
        }
    }
}

struct EpiZ {
    static constexpr bool PERM = true;
    float* ZF; bf16* ZB;
    __device__ __forceinline__ void operator()(const f32x4 (&acc)[2][2][4][2], const pg8::Unit& u, int wr, int wc, int fr, int fq) const {
        const int row0 = u.pm * 256 + wr * 64 + fr, cl = wc * 32 + 8 * fq;
        if (u.pn <= 2 || u.pn == 15) {
            const int cb = (u.pn == 15 ? 768 : u.pn * 256) + cl;
#pragma unroll
            for (int ai = 0; ai < 2; ++ai)
#pragma unroll
                for (int m = 0; m < 4; ++m) { float* rp = ZF + (size_t)(row0 + ai * 128 + m * 16) * 1024 + cb;
#pragma unroll
                    for (int bj = 0; bj < 2; ++bj) { *(f32x4*)(rp + bj * 128) = acc[ai][bj][m][0]; *(f32x4*)(rp + bj * 128 + 4) = acc[ai][bj][m][1]; } }
        } else {
            const int cb = (u.pn - 3) * 256 + cl;
#pragma unroll
            for (int ai = 0; ai < 2; ++ai)
#pragma unroll
                for (int m = 0; m < 4; ++m) { bf16* rp = ZB + (size_t)(row0 + ai * 128 + m * 16) * 3072 + cb;
#pragma unroll
                    for (int bj = 0; bj < 2; ++bj) { const f32x4 v0 = acc[ai][bj][m][0], v1 = acc[ai][bj][m][1]; v4u w;
                        w.x = cvt_pk_bf16(v0[0], v0[1]); w.y = cvt_pk_bf16(v0[2], v0[3]); w.z = cvt_pk_bf16(v1[0], v1[1]); w.w = cvt_pk_bf16(v1[2], v1[3]); *(v4u*)(rp + bj * 128) = w; } }
        }
    }
};
struct EpiQ {
    static constexpr bool PERM = true;
    bf16* QLAT; bf16* QIDX;
    __device__ __forceinline__ void operator()(const f32x4 (&acc)[2][2][4][2], const pg8::Unit& u, int wr, int wc, int fr, int fq) const {
        const int row0 = u.pm * 256 + wr * 64 + fr, cl = wc * 32 + 8 * fq;
        bf16* base; int ld, cb;
        if (u.pn < 8) { base = QLAT; ld = 2048; cb = u.pn * 256 + cl; } else { base = QIDX; ld = 512; cb = (u.pn - 8) * 256 + cl; }
#pragma unroll
        for (int ai = 0; ai < 2; ++ai)
#pragma unroll
            for (int m = 0; m < 4; ++m) { bf16* rp = base + (size_t)(row0 + ai * 128 + m * 16) * ld + cb;
#pragma unroll
                for (int bj = 0; bj < 2; ++bj) { const f32x4 v0 = acc[ai][bj][m][0], v1 = acc[ai][bj][m][1]; v4u w;
                    w.x = cvt_pk_bf16(v0[0], v0[1]); w.y = cvt_pk_bf16(v0[2], v0[3]); w.z = cvt_pk_bf16(v1[0], v1[1]); w.w = cvt_pk_bf16(v1[2], v1[3]); *(v4u*)(rp + bj * 128) = w; } }
    }
};
struct EpiRes {
    static constexpr bool PERM = false;
    const float* Xin; float* X1; const float* g1;
    __device__ __forceinline__ void operator()(const f32x4 (&acc)[2][2][4][2], const pg8::Unit& u, int wr, int wc, int fr, int fq) const {
        const int row0 = u.pm * 256 + wr * 64 + fr, col0 = u.pn * 256 + wc * 32 + 4 * fq; const int b = (u.pm * 256) / SEQ;
        f32x4 gv[2][2];
#pragma unroll
        for (int bj = 0; bj < 2; ++bj)
#pragma unroll
            for (int n = 0; n < 2; ++n) gv[bj][n] = *(const f32x4*)(g1 + (size_t)b * 12288 + col0 + bj * 128 + n * 16);
#pragma unroll
        for (int ai = 0; ai < 2; ++ai)
#pragma unroll
            for (int m = 0; m < 4; ++m) { const size_t off = (size_t)(row0 + ai * 128 + m * 16) * D + col0;
#pragma unroll
                for (int bj = 0; bj < 2; ++bj)
#pragma unroll
                    for (int n = 0; n < 2; ++n) { const f32x4 xi = *(const f32x4*)(Xin + off + bj * 128 + n * 16); *(f32x4*)(X1 + off + bj * 128 + n * 16) = xi + gv[bj][n] * acc[ai][bj][m][n]; } }
    }
};
struct MoeOrder {
    const int* tile_e; int ntiles, npn, G, c;
    __device__ __forceinline__ bool next(int i, pg8::Unit& u) const { const int L = i * G + c; if (L >= ntiles * npn) return false; const int tile = L / npn, pn = L % npn; u.pm = tile; u.pn = tile_e[tile] * npn + pn; return true; }
    __device__ __forceinline__ void a_ready(const pg8::Unit&) const {}
    __device__ __forceinline__ void done(const pg8::Unit&) const {}
};
struct EpiGU {
    static constexpr bool PERM = true;
    bf16* ACT;
    __device__ __forceinline__ void operator()(const f32x4 (&acc)[2][2][4][2], const pg8::Unit& u, int wr, int wc, int fr, int fq) const {
        const int row0 = u.pm * 256 + wr * 64 + fr, cb = (u.pn & 3) * 128 + wc * 32 + 8 * fq;
#pragma unroll
        for (int ai = 0; ai < 2; ++ai)
#pragma unroll
            for (int m = 0; m < 4; ++m) { float o[8];
#pragma unroll
                for (int n = 0; n < 2; ++n)
#pragma unroll
                    for (int e = 0; e < 4; ++e) { const float g = acc[ai][0][m][n][e], up = acc[ai][1][m][n][e]; o[n * 4 + e] = g / (1.f + __expf(-g)) * up; }
                v4u w; w.x = cvt_pk_bf16(o[0], o[1]); w.y = cvt_pk_bf16(o[2], o[3]); w.z = cvt_pk_bf16(o[4], o[5]); w.w = cvt_pk_bf16(o[6], o[7]);
                *(v4u*)(ACT + (size_t)(row0 + ai * 128 + m * 16) * 512 + cb) = w; }
    }
};
struct EpiDN {
    static constexpr bool PERM = true;
    bf16* YS; const float* rowgate;
    __device__ __forceinline__ void operator()(const f32x4 (&acc)[2][2][4][2], const pg8::Unit& u, int wr, int wc, int fr, int fq) const {
        const int row0 = u.pm * 256 + wr * 64 + fr, cb = (u.pn & 7) * 256 + wc * 32 + 8 * fq;
#pragma unroll
        for (int ai = 0; ai < 2; ++ai)
#pragma unroll
            for (int m = 0; m < 4; ++m) { const int r = row0 + ai * 128 + m * 16; const float gt = rowgate[r]; bf16* rp = YS + (size_t)r * D + cb;
#pragma unroll
                for (int bj = 0; bj < 2; ++bj) { const f32x4 v0 = acc[ai][bj][m][0] * gt, v1 = acc[ai][bj][m][1] * gt; v4u w;
                    w.x = cvt_pk_bf16(v0[0], v0[1]); w.y = cvt_pk_bf16(v0[2], v0[3]); w.z = cvt_pk_bf16(v1[0], v1[1]); w.w = cvt_pk_bf16(v1[2], v1[3]); *(v4u*)(rp + bj * 128) = w; } }
    }
};

__device__ __forceinline__ float wave_scan_add(float v, int lane) {
#pragma unroll
    for (int o = 1; o < 64; o <<= 1) { const float t = __shfl_up(v, o); if (lane >= o) v += t; }
    return v;
}
__device__ __forceinline__ float wave_scan_max(float v, int lane) {
#pragma unroll
    for (int o = 1; o < 64; o <<= 1) { const float t = __shfl_up(v, o); if (lane >= o) v = fmaxf(v, t); }
    return v;
}
__device__ __forceinline__ void p3_phase(Frame& F, const float* __restrict__ ZF, const float* __restrict__ gq, const float* __restrict__ gkv, const float* __restrict__ ib, const float* __restrict__ fb,
                                         bf16* CQN, bf16* CKVN, bf16* KIDX, float* GA, float* GMX, float* GB, float* MINS) {
    const int gw = blockIdx.x * NWAVES + F.wave, NGW = F.G * NWAVES;
    for (int chain = gw; chain < 16 * NWAVES; chain += NGW) {
        if ((chain & 7) != 0) continue;
        const int ch = chain >> 3, b = ch >> 2, h = ch & 3; const float ibias = ib[h], fbias = fb[h];
        float m_in = 0.f;
        for (int k0 = 0; k0 < 64; k0 += 8) {
            float miv[8], mfv[8];
#pragma unroll
            for (int u = 0; u < 8; ++u) { const int t = b * SEQ + 64 * (k0 + u) + F.lane; miv[u] = ZF[(size_t)t * 1024 + 768 + 72 + h]; mfv[u] = ZF[(size_t)t * 1024 + 768 + 76 + h]; }
#pragma unroll
            for (int u = 0; u < 8; ++u) {
                const int k = k0 + u, t = b * SEQ + 64 * k + F.lane;
                const float mi = miv[u] + ibias, mf = mfv[u] + fbias;
                const float lf = fminf(mf, 0.f) - log1pf(__expf(-fabsf(mf)));
                const float bj = wave_scan_add(lf, F.lane);
                const float a = mi - bj;
                const float mx = fmaxf(m_in, wave_scan_max(a, F.lane));
                GA[t * 4 + h] = a; GMX[t * 4 + h] = mx; GB[t * 4 + h] = bj;
                if (F.lane == 0) MINS[ch * 65 + k] = m_in;
                m_in = __shfl(bj, 63) + __shfl(mx, 63);
            }
        }
        if (F.lane == 0) MINS[ch * 65 + 64] = m_in;
    }
    for (int rb = gw; rb < T / 8; rb += NGW) {
        const f32x4 g0 = *(const f32x4*)(gq + 4 * F.lane), g1 = *(const f32x4*)(gq + 256 + 4 * F.lane), g2 = *(const f32x4*)(gkv + 4 * F.lane);
        for (int r = rb * 8; r < rb * 8 + 8; ++r) {
            const float* zr = ZF + (size_t)r * 1024;
            const f32x4 a0 = *(const f32x4*)(zr + 4 * F.lane), a1 = *(const f32x4*)(zr + 256 + 4 * F.lane), kv = *(const f32x4*)(zr + 512 + 4 * F.lane);
            const float ki = zr[768 + F.lane];
            float s1 = (a0.x * a0.x + a0.y * a0.y) + (a0.z * a0.z + a0.w * a0.w) + (a1.x * a1.x + a1.y * a1.y) + (a1.z * a1.z + a1.w * a1.w);
            float s2 = (kv.x * kv.x + kv.y * kv.y) + (kv.z * kv.z + kv.w * kv.w);
            const float r1 = 1.0f / sqrtf(wave_sum(s1) * (1.f / 512.f) + EPS), r2 = 1.0f / sqrtf(wave_sum(s2) * (1.f / 256.f) + EPS);
            const f32x4 y0 = a0 * r1 * g0, y1 = a1 * r1 * g1, y2 = kv * r2 * g2;
            v2u w; w.x = cvt_pk_bf16(y0.x, y0.y); w.y = cvt_pk_bf16(y0.z, y0.w); *((v2u*)(CQN + (size_t)r * 512) + F.lane) = w;
            w.x = cvt_pk_bf16(y1.x, y1.y); w.y = cvt_pk_bf16(y1.z, y1.w); *((v2u*)(CQN + (size_t)r * 512 + 256) + F.lane) = w;
            w.x = cvt_pk_bf16(y2.x, y2.y); w.y = cvt_pk_bf16(y2.z, y2.w); *((v2u*)(CKVN + (size_t)r * 256) + F.lane) = w;
            KIDX[(size_t)r * 64 + F.lane] = (bf16)(cvt_pk_bf16(ki, 0.f) & 0xffffu);
        }
    }
}

__device__ __forceinline__ void m1_scan(Frame& F, const bf16* __restrict__ ZB, const float* __restrict__ GA, const float* __restrict__ GMX, const float* __restrict__ MINS, bf16* CT, float* NS) {
    LAS bf16* kT = (LAS bf16*)(F.lds); LAS bf16* vT = (LAS bf16*)(F.lds + 2 * 128 * 72 * 2);
    const int g = F.lane >> 4, n = F.lane & 15, w = F.wave;
    for (int unit = blockIdx.x; unit < 256; unit += F.G) {
        const int chain = unit >> 4, sl = unit & 15, b = chain >> 2, h = chain & 3; const int bt0 = b * SEQ;
        const int s = F.tid >> 3, dc = F.tid & 7;
        f32x4 C = (f32x4){0.f, 0.f, 0.f, 0.f}, Nacc = (f32x4){0.f, 0.f, 0.f, 0.f};
        bf16x8 ones; for (int i = 0; i < 8; ++i) ones[i] = (short)0x3F80;
        v4u kr0, kr1, vr; float wsv;
        { const int t = bt0 + s; const bf16* kp = ZB + (size_t)t * 3072 + 512 + h * 128 + dc * 16; kr0 = *(const v4u*)kp; kr1 = *(const v4u*)(kp + 8);
          vr = (v4u){0u, 0u, 0u, 0u}; if (F.tid < 128) vr = *(const v4u*)(ZB + (size_t)(bt0 + (F.tid >> 1)) * 3072 + 1024 + h * 256 + sl * 16 + (F.tid & 1) * 8);
          wsv = __expf(GA[t * 4 + h] - GMX[(bt0 + 63) * 4 + h]); }
        __syncthreads();
        for (int k = 0; k < 64; ++k) {
            const int buf = k & 1; LAS bf16* kTb = kT + buf * 128 * 72; LAS bf16* vTb = vT + buf * 16 * 72;
            { const unsigned kk[8] = {kr0.x, kr0.y, kr0.z, kr0.w, kr1.x, kr1.y, kr1.z, kr1.w};
#pragma unroll
              for (int i = 0; i < 8; ++i) { const unsigned u = cvt_pk_bf16(bf_lo(kk[i]) * wsv, bf_hi(kk[i]) * wsv);
                  kTb[(dc * 16 + 2 * i) * 72 + s] = (bf16)(u & 0xffffu); kTb[(dc * 16 + 2 * i + 1) * 72 + s] = (bf16)(u >> 16); }
              if (F.tid < 128) { const unsigned vv[4] = {vr.x, vr.y, vr.z, vr.w}; const int vs = F.tid >> 1, e8 = (F.tid & 1) * 8;
#pragma unroll
                  for (int i = 0; i < 4; ++i) { vTb[(e8 + 2 * i) * 72 + vs] = (bf16)(vv[i] & 0xffffu); vTb[(e8 + 2 * i + 1) * 72 + vs] = (bf16)(vv[i] >> 16); } } }
            const float w_old = __expf(MINS[chain * 65 + k] - GMX[(bt0 + 64 * k + 63) * 4 + h]);
            if (k + 1 < 64) { const int t = bt0 + 64 * (k + 1) + s; const bf16* kp = ZB + (size_t)t * 3072 + 512 + h * 128 + dc * 16; kr0 = *(const v4u*)kp; kr1 = *(const v4u*)(kp + 8);
                if (F.tid < 128) vr = *(const v4u*)(ZB + (size_t)(bt0 + 64 * (k + 1) + (F.tid >> 1)) * 3072 + 1024 + h * 256 + sl * 16 + (F.tid & 1) * 8);
                wsv = __expf(GA[t * 4 + h] - GMX[(bt0 + 64 * (k + 1) + 63) * 4 + h]); }
            __syncthreads();
            { bf16* cp = CT + ((size_t)(chain * 64 + k) * 256 + sl * 16 + 4 * g) * 128 + 16 * w + n;
#pragma unroll
              for (int i = 0; i < 4; ++i) cp[(size_t)i * 128] = (bf16)(cvt_pk_bf16(C[i], 0.f) & 0xffffu);
              if (sl == 0 && g == 0) NS[(size_t)(chain * 64 + k) * 128 + 16 * w + n] = Nacc[0]; }
            C = C * w_old; Nacc = Nacc * w_old;
#pragma unroll
            for (int ks = 0; ks < 2; ++ks) {
                const bf16x8 Af = *(const LAS bf16x8*)(vTb + n * 72 + 32 * ks + 8 * g);
                const bf16x8 Bf = *(const LAS bf16x8*)(kTb + (16 * w + n) * 72 + 32 * ks + 8 * g);
                C = __builtin_amdgcn_mfma_f32_16x16x32_bf16(Af, Bf, C, 0, 0, 0);
                Nacc = __builtin_amdgcn_mfma_f32_16x16x32_bf16(ones, Bf, Nacc, 0, 0, 0);
            }
        }
        __syncthreads();
    }
}

__device__ __forceinline__ void m3_out(Frame& F, const bf16* __restrict__ ZB, const float* __restrict__ GA, const float* __restrict__ GMX, const float* __restrict__ GB, const float* __restrict__ MINS,
                                       const bf16* __restrict__ CT, const float* __restrict__ NS, const float* __restrict__ gn, bf16* AO) {
    LAS bf16* vT = (LAS bf16*)(F.lds); LAS bf16* scT = (LAS bf16*)(F.lds + 36864);
    LAS float* den = (LAS float*)(F.lds + 46080); LAS float* qn = den + 64; LAS float* nin = den + 192;
    LAS float* denp = (LAS float*)(F.lds + 47616);
    LAS float* ssp = denp + 256;
    const int g = F.lane >> 4, n = F.lane & 15, w = F.wave;
    const float qs = 0.08838834764831845f;
    for (int unit = blockIdx.x; unit < 1024; unit += F.G) {
        const int chain = unit >> 6, k = unit & 63, b = chain >> 2, h = chain & 3; const int t0 = b * SEQ + 64 * k;
        __syncthreads();
        { const int s = F.tid >> 3, ec = F.tid & 7; const bf16* vp = ZB + (size_t)(t0 + s) * 3072 + 1024 + h * 256 + ec * 32;
#pragma unroll
          for (int q = 0; q < 4; ++q) { const v4u v = *(const v4u*)(vp + 8 * q); const unsigned vv[4] = {v.x, v.y, v.z, v.w};
#pragma unroll
              for (int i = 0; i < 4; ++i) { vT[(ec * 32 + 8 * q + 2 * i) * 72 + s] = (bf16)(vv[i] & 0xffffu); vT[(ec * 32 + 8 * q + 2 * i + 1) * 72 + s] = (bf16)(vv[i] >> 16); } }
          if (F.tid < 128) nin[F.tid] = NS[(size_t)(chain * 64 + k) * 128 + F.tid];
          }
        __syncthreads();
        const float m_in = MINS[chain * 65 + k];
#pragma unroll
        for (int ti = 0; ti < 2; ++ti) {
            const int id = 2 * w + ti, st = id >> 2, jt = id & 3;
            f32x4 acc = (f32x4){0.f, 0.f, 0.f, 0.f};
            if (st <= jt) {
#pragma unroll
                for (int ks = 0; ks < 4; ++ks) {
                    const bf16x8 Af = *(const bf16x8*)(ZB + (size_t)(t0 + 16 * st + n) * 3072 + 512 + h * 128 + 32 * ks + 8 * g);
                    const bf16x8 Bf = *(const bf16x8*)(ZB + (size_t)(t0 + 16 * jt + n) * 3072 + h * 128 + 32 * ks + 8 * g);
                    acc = __builtin_amdgcn_mfma_f32_16x16x32_bf16(Af, Bf, acc, 0, 0, 0);
                }
            }
            const int j = 16 * jt + n; const float mxj = GMX[(t0 + j) * 4 + h];
            float v[4], rs = 0.f;
#pragma unroll
            for (int i = 0; i < 4; ++i) { const int s = 16 * st + 4 * g + i; const float a = GA[(t0 + s) * 4 + h]; v[i] = (s <= j) ? acc[i] * qs * __expf(a - mxj) : 0.f; rs += v[i]; }
            rs += __shfl_xor(rs, 16); rs += __shfl_xor(rs, 32);
            if (g == 0) denp[st * 64 + j] = rs;
            v2u pk; pk.x = cvt_pk_bf16(v[0], v[1]); pk.y = cvt_pk_bf16(v[2], v[3]);
            *(LAS v2u*)(scT + j * 72 + 16 * st + 4 * g) = pk;
        }
        { const int j = F.tid >> 3, dc = F.tid & 7; const bf16* qp = ZB + (size_t)(t0 + j) * 3072 + h * 128 + dc * 16; const v4u q0 = *(const v4u*)qp, q1 = *(const v4u*)(qp + 8);
          const unsigned qq[8] = {q0.x, q0.y, q0.z, q0.w, q1.x, q1.y, q1.z, q1.w}; float p = 0.f;
#pragma unroll
          for (int i = 0; i < 8; ++i) p += bf_lo(qq[i]) * nin[dc * 16 + 2 * i] + bf_hi(qq[i]) * nin[dc * 16 + 2 * i + 1];
          p += __shfl_xor(p, 1); p += __shfl_xor(p, 2); p += __shfl_xor(p, 4);
          if (dc == 0) qn[j] = p * qs; }
        __syncthreads();
        f32x4 acc[2][4];
#pragma unroll
        for (int mt = 0; mt < 2; ++mt)
#pragma unroll
            for (int jt = 0; jt < 4; ++jt) acc[mt][jt] = (f32x4){0.f, 0.f, 0.f, 0.f};
#pragma unroll
        for (int ks = 0; ks < 4; ++ks) {
            bf16x8 Af[2], Bf[4];
#pragma unroll
            for (int mt = 0; mt < 2; ++mt) Af[mt] = *(const bf16x8*)(CT + ((size_t)(chain * 64 + k) * 256 + 32 * w + 16 * mt + n) * 128 + 32 * ks + 8 * g);
#pragma unroll
            for (int jt = 0; jt < 4; ++jt) Bf[jt] = *(const bf16x8*)(ZB + (size_t)(t0 + 16 * jt + n) * 3072 + h * 128 + 32 * ks + 8 * g);
#pragma unroll
            for (int mt = 0; mt < 2; ++mt)
#pragma unroll
                for (int jt = 0; jt < 4; ++jt) acc[mt][jt] = __builtin_amdgcn_mfma_f32_16x16x32_bf16(Af[mt], Bf[jt], acc[mt][jt], 0, 0, 0);
        }
        float winter[4], dn[4];
#pragma unroll
        for (int jt = 0; jt < 4; ++jt) { const int j = 16 * jt + n; const float mxj = GMX[(t0 + j) * 4 + h], bj = GB[(t0 + j) * 4 + h];
            winter[jt] = __expf(m_in - mxj); const float dd = winter[jt] * qn[j] + (((denp[j] + denp[64 + j]) + denp[128 + j]) + denp[192 + j]); dn[jt] = fmaxf(fabsf(dd), __expf(-(bj + mxj)));
#pragma unroll
            for (int mt = 0; mt < 2; ++mt) acc[mt][jt] = acc[mt][jt] * (winter[jt] * qs); }
#pragma unroll
        for (int ks = 0; ks < 2; ++ks) {
            bf16x8 Af[2], Bf[4];
#pragma unroll
            for (int mt = 0; mt < 2; ++mt) Af[mt] = *(const LAS bf16x8*)(vT + (32 * w + 16 * mt + n) * 72 + 32 * ks + 8 * g);
#pragma unroll
            for (int jt = 0; jt < 4; ++jt) Bf[jt] = *(const LAS bf16x8*)(scT + (16 * jt + n) * 72 + 32 * ks + 8 * g);
#pragma unroll
            for (int mt = 0; mt < 2; ++mt)
#pragma unroll
                for (int jt = 0; jt < 4; ++jt) acc[mt][jt] = __builtin_amdgcn_mfma_f32_16x16x32_bf16(Af[mt], Bf[jt], acc[mt][jt], 0, 0, 0);
        }
#pragma unroll
        for (int jt = 0; jt < 4; ++jt) { const float inv = 1.0f / dn[jt]; float q = 0.f;
#pragma unroll
            for (int mt = 0; mt < 2; ++mt) { acc[mt][jt] = acc[mt][jt] * inv; const f32x4 a = acc[mt][jt]; q += (a.x * a.x + a.y * a.y) + (a.z * a.z + a.w * a.w); }
            q += __shfl_xor(q, 16); q += __shfl_xor(q, 32);
            if (g == 0) ssp[w * 64 + 16 * jt + n] = q; }
        __syncthreads();
#pragma unroll
        for (int jt = 0; jt < 4; ++jt) { const int j = 16 * jt + n; float sq = 0.f;
#pragma unroll
            for (int w8 = 0; w8 < 8; ++w8) sq += ssp[w8 * 64 + j];
            const float rstd = 1.0f / sqrtf(sq * (1.f / 256.f) + EPS);
#pragma unroll
            for (int mt = 0; mt < 2; ++mt) { const int e = 32 * w + 16 * mt + 4 * g; const f32x4 gv = *(const f32x4*)(gn + h * 256 + e);
                const v2u mo = *(const v2u*)(ZB + (size_t)(t0 + j) * 3072 + 2048 + h * 256 + e);
                const float o0 = bf_lo(mo.x), o1 = bf_hi(mo.x), o2 = bf_lo(mo.y), o3 = bf_hi(mo.y);
                const f32x4 a = acc[mt][jt] * rstd * gv;
                v2u pk; pk.x = cvt_pk_bf16(a.x / (1.f + __expf(-o0)), a.y / (1.f + __expf(-o1))); pk.y = cvt_pk_bf16(a.z / (1.f + __expf(-o2)), a.w / (1.f + __expf(-o3)));
                *(v2u*)(AO + (size_t)(t0 + j) * 3072 + 2048 + h * 256 + e) = pk; } }
    }
    __syncthreads();
}

__device__ __forceinline__ unsigned off_b(unsigned row, unsigned ch) { return 256u * row + 16u * (ch ^ (((row & 3u) << 2) | ((row >> 2) & 3u))); }
__device__ __forceinline__ v2u tr_read2(unsigned a0, unsigned a1, v2u& r1) { v2u r0; asm volatile("ds_read_b64_tr_b16 %0, %2\n\tds_read_b64_tr_b16 %1, %3\n\ts_waitcnt lgkmcnt(0)" : "=&v"(r0), "=&v"(r1) : "v"(a0), "v"(a1) : "memory"); return r0; }

__device__ __forceinline__ void dsa_phase(Frame& F, const bf16* __restrict__ QIDX, const bf16* __restrict__ KIDX, const float* __restrict__ ZF, const bf16* __restrict__ QLAT, const bf16* __restrict__ CKVN, bf16* AO) {
    const int lane = F.lane, w = F.wave;
    LAS float* SC = (LAS float*)(F.lds);
    LAS unsigned char* kvimg = F.lds + w * 16384;
    LAS int* list = (LAS int*)(F.lds + 131072 + w * 1024);
    const unsigned kvbase = (unsigned)(size_t)kvimg;
    for (int it = 0; it < 8; ++it) {
        const int vb = blockIdx.x;
        for (int blk = vb; blk < 256; blk += F.G) {
        const int b = it >> 1, gi = (it & 1) ? (511 - blk) : blk;
        const int p0 = gi * 8, t0 = b * SEQ + p0, bt0 = b * SEQ;
        __syncthreads();
#ifndef DSA_NO_SCORE
        {
            int lo_ = lane; asm volatile("" : "+v"(lo_));
            const int hf = lo_ >> 5, n32 = lo_ & 31;
            bf16x8 Aq[2][4]; float wv[2][16];
            const int m = n32, qloc = 2 * (m >> 4) + ((m >> 2) & 1), hd = 4 * ((m >> 3) & 1) + (m & 3);
#pragma unroll
            for (int a = 0; a < 2; ++a)
#pragma unroll
                for (int ks = 0; ks < 4; ++ks) Aq[a][ks] = *(const bf16x8*)(QIDX + (size_t)(t0 + 4 * a + qloc) * 512 + hd * 64 + ks * 16 + hf * 8);
#pragma unroll
            for (int a = 0; a < 2; ++a)
#pragma unroll
                for (int i = 0; i < 16; ++i) wv[a][i] = ZF[(size_t)(t0 + 4 * a + 2 * (i >> 3) + hf) * 1024 + 768 + 64 + (i & 7)];
            const int nkt = (p0 + 7) / 32 + 1;
            for (int kt = w; kt < nkt; kt += NWAVES) {
                bf16x8 Bk[4];
#pragma unroll
                for (int ks = 0; ks < 4; ++ks) Bk[ks] = *(const bf16x8*)(KIDX + (size_t)(bt0 + 32 * kt + n32) * 64 + ks * 16 + hf * 8);
#pragma unroll
                for (int a = 0; a < 2; ++a) {
                    f32x16 acc; for (int i = 0; i < 16; ++i) acc[i] = 0.f;
#pragma unroll
                    for (int ks = 0; ks < 4; ++ks) acc = __builtin_amdgcn_mfma_f32_32x32x16_bf16(Aq[a][ks], Bk[ks], acc, 0, 0, 0);
                    float s0 = 0.f, s1 = 0.f;
#pragma unroll
                    for (int i = 0; i < 8; ++i) { s0 += wv[a][i] * fmaxf(acc[i], 0.f); s1 += wv[a][8 + i] * fmaxf(acc[8 + i], 0.f); }
                    SC[(4 * a + hf) * 4096 + 32 * kt + n32] = s0; SC[(4 * a + 2 + hf) * 4096 + 32 * kt + n32] = s1;
                }
            }
        }
#endif
        __syncthreads();
        const int p = p0 + w, t = t0 + w; int count;
        if (p < 256) { count = p + 1;
#pragma unroll
            for (int i = 0; i < 4; ++i) { const int idx = 64 * i + lane; list[idx] = idx <= p ? idx : 0; }
        } else {
            count = 256;
#ifndef DSA_NO_SEL
            unsigned key[64];
            const LAS float* srow = SC + w * 4096;
#pragma unroll
            for (int i = 0; i < 64; ++i) { const int s = 64 * i + lane; unsigned u = 0u;
                if (64 * i <= p) { const unsigned bits = __builtin_bit_cast(unsigned, srow[s]); u = (bits & 0x80000000u) ? ~bits : (bits | 0x80000000u); if (s > p) u = 0u; }
                key[i] = u; }
            unsigned Tm = 0u; int cge = 0; bool exact = false;
            for (int bit = 31; bit >= 0; --bit) {
                const unsigned cand = Tm | (1u << bit); int c = 0;
#pragma unroll
                for (int i = 0; i < 64; ++i) c += __popcll(__ballot(key[i] >= cand));
                if (c >= 256) { Tm = cand; cge = c; if (c == 256) { exact = true; break; } }
            }
            (void)cge; (void)exact;
            int base = 0;
#pragma unroll
            for (int i = 0; i < 64; ++i) { const bool pr = key[i] > Tm; const unsigned long long mk = __ballot(pr); const int pos = base + __builtin_amdgcn_mbcnt_hi((unsigned)(mk >> 32), __builtin_amdgcn_mbcnt_lo((unsigned)mk, 0u));
                if (pr) list[pos] = 64 * i + lane; base += __popcll(mk); }
#pragma unroll
            for (int i = 0; i < 64; ++i) { const bool pr = key[i] == Tm; const unsigned long long mk = __ballot(pr); const int pos = base + __builtin_amdgcn_mbcnt_hi((unsigned)(mk >> 32), __builtin_amdgcn_mbcnt_lo((unsigned)mk, 0u));
                if (pr && pos < 256) list[pos] = 64 * i + lane; base += __popcll(mk); }
#endif
        }
        LDS_WAIT(); asm volatile("" ::: "memory");
#ifndef DSA_NO_ATT
        {
            int lo_ = lane; asm volatile("" : "+v"(lo_));
            const int hf = lo_ >> 5, n32 = lo_ & 31, g = lo_ >> 4, n = lo_ & 15;
            bf16x8 qb[8];
#pragma unroll
            for (int s = 0; s < 8; ++s) { if (n < 8) qb[s] = *(const bf16x8*)(QLAT + (size_t)t * 2048 + n * 256 + 32 * s + 8 * g); else { for (int i = 0; i < 8; ++i) qb[s][i] = 0; } }
            f32x4 O[16];
#pragma unroll
            for (int c = 0; c < 16; ++c) O[c] = (f32x4){0.f, 0.f, 0.f, 0.f};
            float m_run = -1e30f, l_run = 0.f;
            const int nch = (count + 31) >> 5;
            const unsigned rowA0 = 8u * (unsigned)(n >> 2) + (unsigned)(n & 3);
            for (int ch = 0; ch < nch; ++ch) {
#pragma unroll
                for (int hh = 0; hh < 2; ++hh) {
                    v4u rg[8];
#pragma unroll
                    for (int i = 0; i < 8; ++i) { const int row = 2 * (8 * hh + i) + hf; const int idx = list[32 * ch + row]; rg[i] = *(const v4u*)(CKVN + (size_t)(bt0 + idx) * 256 + n32 * 8); }
#pragma unroll
                    for (int i = 0; i < 8; ++i) { const unsigned row = 2u * (8 * hh + i) + hf; *(LAS v4u*)(kvimg + (n32 >> 4) * 8192 + off_b(row, n32 & 15)) = rg[i]; }
                }
                LDS_WAIT(); asm volatile("" ::: "memory");
                f32x4 st[2];
#pragma unroll
                for (int rb = 0; rb < 2; ++rb) { st[rb] = (f32x4){0.f, 0.f, 0.f, 0.f};
#pragma unroll
                    for (int s = 0; s < 8; ++s) { const bf16x8 a = *(const LAS bf16x8*)(kvimg + (s >> 2) * 8192 + off_b(rowA0 + 4u * rb, 4u * (s & 3) + g));
                        st[rb] = __builtin_amdgcn_mfma_f32_16x16x32_bf16(a, qb[s], st[rb], 0, 0, 0); } }
                float pv[8]; float mx = -1e30f;
#pragma unroll
                for (int rb = 0; rb < 2; ++rb)
#pragma unroll
                    for (int i = 0; i < 4; ++i) { const int kp = 32 * ch + 8 * g + 4 * rb + i; const float sv = (kp < count) ? st[rb][i] : -1e30f; pv[rb * 4 + i] = sv; mx = fmaxf(mx, sv); }
                mx = fmaxf(mx, __shfl_xor(mx, 16)); mx = fmaxf(mx, __shfl_xor(mx, 32));
                const float m_new = fmaxf(m_run, mx), alpha = exp2f(m_run - m_new); m_run = m_new;
                float ps = 0.f;
#pragma unroll
                for (int i = 0; i < 8; ++i) { pv[i] = exp2f(pv[i] - m_new); ps += pv[i]; }
                l_run = l_run * alpha + ps;
#pragma unroll
                for (int c = 0; c < 16; ++c) O[c] = O[c] * alpha;
                bf16x8 pb; { v4u pk; pk.x = cvt_pk_bf16(pv[0], pv[1]); pk.y = cvt_pk_bf16(pv[2], pv[3]); pk.z = cvt_pk_bf16(pv[4], pv[5]); pk.w = cvt_pk_bf16(pv[6], pv[7]); pb = __builtin_bit_cast(bf16x8, pk); }
                const unsigned q4 = (unsigned)(n >> 2), p4 = (unsigned)(n & 3);
#pragma unroll
                for (int c = 0; c < 16; ++c) {
                    const unsigned ib = kvbase + (unsigned)(c >> 3) * 8192u, cc = (unsigned)(c & 7);
                    const unsigned a0 = ib + off_b(8u * g + q4, 2u * cc + (p4 >> 1)) + 8u * (p4 & 1u), a1 = ib + off_b(8u * g + 4u + q4, 2u * cc + (p4 >> 1)) + 8u * (p4 & 1u);
                    v2u r1; const v2u r0 = tr_read2(a0, a1, r1);
                    v4u av; av.x = r0.x; av.y = r0.y; av.z = r1.x; av.w = r1.y;
                    O[c] = __builtin_amdgcn_mfma_f32_16x16x32_bf16(__builtin_bit_cast(bf16x8, av), pb, O[c], 0, 0, 0);
                }
            }
            float lt = l_run; lt += __shfl_xor(lt, 16); lt += __shfl_xor(lt, 32);
            const float inv = 1.0f / lt;
            if (n < 8) {
#pragma unroll
                for (int c = 0; c < 16; ++c) { const f32x4 o = O[c] * inv; v2u pk; pk.x = cvt_pk_bf16(o.x, o.y); pk.y = cvt_pk_bf16(o.z, o.w);
                    *(v2u*)(AO + (size_t)t * 3072 + n * 256 + 16 * c + 4 * g) = pk; }
            }
        }
#endif
        }
    }
    __syncthreads();
}

__device__ __forceinline__ void router_phase(Frame& F, const bf16* __restrict__ H, const bf16* __restrict__ WR, const float* __restrict__ rbias, int* ecnt, int* EIDX, float* GATE, int* RANK) {
    LAS float* lg = (LAS float*)(F.lds) + F.wave * (16 * 33);
    LAS int* hist = (LAS int*)(F.lds + 32768); LAS int* basee = hist + 32;
    const int g = F.lane >> 4, n = F.lane & 15;
    for (int tb = blockIdx.x; tb < 256; tb += F.G) {
        __syncthreads();
        if (F.tid < 32) hist[F.tid] = 0;
        __syncthreads();
        int e0 = 0, e1 = 0, lr0 = 0, lr1 = 0; float g0 = 0.f, g1 = 0.f; const int r0 = tb * 64 + F.wave * 16;
        if (F.wave < 4) {
            f32x4 acc[2] = {(f32x4){0.f, 0.f, 0.f, 0.f}, (f32x4){0.f, 0.f, 0.f, 0.f}};
            for (int s = 0; s < 64; ++s) {
                const bf16x8 Af = *(const bf16x8*)(H + (size_t)(r0 + n) * D + 32 * s + 8 * g);
#pragma unroll
                for (int nt = 0; nt < 2; ++nt) { const bf16x8 Bf = *(const bf16x8*)(WR + (size_t)(16 * nt + n) * D + 32 * s + 8 * g); acc[nt] = __builtin_amdgcn_mfma_f32_16x16x32_bf16(Af, Bf, acc[nt], 0, 0, 0); }
            }
#pragma unroll
            for (int nt = 0; nt < 2; ++nt)
#pragma unroll
                for (int i = 0; i < 4; ++i) lg[(4 * g + i) * 33 + 16 * nt + n] = acc[nt][i];
            LDS_WAIT(); asm volatile("" ::: "memory");
            if (F.lane < 16) {
                const LAS float* row = lg + F.lane * 33;
                float best = -1e30f; int bg = 0;
                for (int gi = 0; gi < 4; ++gi) { float m1 = -1e30f, m2 = -1e30f;
                    for (int j = 0; j < 8; ++j) { const int e = gi * 8 + j; const float sel = 1.f / (1.f + __expf(-row[e])) + rbias[e]; if (sel > m1) { m2 = m1; m1 = sel; } else if (sel > m2) m2 = sel; }
                    const float gs = m1 + m2; if (gs > best) { best = gs; bg = gi; } }
                float m1 = -1e30f, m2 = -1e30f; int i1 = 0, i2 = 0;
                for (int j = 0; j < 8; ++j) { const int e = bg * 8 + j; const float sel = 1.f / (1.f + __expf(-row[e])) + rbias[e];
                    if (sel > m1) { m2 = m1; i2 = i1; m1 = sel; i1 = j; } else if (sel > m2) { m2 = sel; i2 = j; } }
                e0 = bg * 8 + i1; e1 = bg * 8 + i2;
                const float a0 = 1.f / (1.f + __expf(-row[e0])), a1 = 1.f / (1.f + __expf(-row[e1]));
                g0 = a0 / (a0 + a1); g1 = a1 / (a0 + a1);
                lr0 = __hip_atomic_fetch_add(&hist[e0], 1, __ATOMIC_RELAXED, __HIP_MEMORY_SCOPE_WORKGROUP); lr1 = __hip_atomic_fetch_add(&hist[e1], 1, __ATOMIC_RELAXED, __HIP_MEMORY_SCOPE_WORKGROUP);
            }
        }
        __syncthreads();
        if (F.tid < 32) basee[F.tid] = atomicAdd(&ecnt[F.tid], hist[F.tid]);
        __syncthreads();
        if (F.wave < 4 && F.lane < 16) { const int t = r0 + F.lane;
            EIDX[2 * t] = e0; EIDX[2 * t + 1] = e1; GATE[2 * t] = g0; GATE[2 * t + 1] = g1; RANK[2 * t] = basee[e0] + lr0; RANK[2 * t + 1] = basee[e1] + lr1; }
    }
    __syncthreads();
}
__device__ __forceinline__ void scatter_phase(Frame& F, const bf16* __restrict__ H, const int* __restrict__ ecnt, const int* __restrict__ EIDX, const float* __restrict__ GATE, const int* __restrict__ RANK,
                                              bf16* XS, int* TOKPOS, float* ROWGATE, int* TILEE, int* NT) {
    LAS int* offs = (LAS int*)(F.lds);
    __syncthreads();
    if (F.tid == 0) { int o = 0; for (int e = 0; e < NE; ++e) { offs[e] = o; o += ((ecnt[e] + 255) >> 8) << 8; } offs[NE] = o; }
    __syncthreads();
    if (blockIdx.x == 0) { if (F.tid < NE) { const int t0 = offs[F.tid] >> 8, t1 = offs[F.tid + 1] >> 8; for (int tt = t0; tt < t1; ++tt) TILEE[tt] = F.tid; } if (F.tid == 0) NT[0] = offs[NE] >> 8; }
    const int gw = blockIdx.x * NWAVES + F.wave, NGW = F.G * NWAVES;
    for (int rb = gw; rb < T / 8; rb += NGW) {
        for (int t = rb * 8; t < rb * 8 + 8; ++t) {
            const v4u* src = (const v4u*)(H + (size_t)t * D) + F.lane; v4u v[4];
#pragma unroll
            for (int j = 0; j < 4; ++j) v[j] = src[64 * j];
#pragma unroll
            for (int kk = 0; kk < 2; ++kk) { const int e = EIDX[2 * t + kk], pos = offs[e] + RANK[2 * t + kk];
                v4u* dst = (v4u*)(XS + (size_t)pos * D) + F.lane;
#pragma unroll
                for (int j = 0; j < 4; ++j) dst[64 * j] = v[j];
                if (F.lane == 0) { TOKPOS[2 * t + kk] = pos; ROWGATE[pos] = GATE[2 * t + kk]; } }
        }
    }
}

constexpr int PH_PER_LAYER = 13, N_PHASES = 1 + 2 * PH_PER_LAYER;
#ifndef PHMASK
#define PHMASK 0xFFFFF
#endif
#define EN(j) (ONLY < 0 ? (((PHMASK) >> (j)) & 1) : (((j) < 14 && ONLY == (j)) || ((j) == 14 && ONLY == 5) || ((j) == 15 && ONLY == 14)))
template <int ONLY> __global__ void __launch_bounds__(NTHR, 2) mk_fwd(Args args) {
    extern __shared__ __attribute__((aligned(16))) unsigned char lds_raw[];
    Frame F; F.lds = (LAS unsigned char*)lds_raw; F.tid = threadIdx.x; F.lane = F.tid & 63; F.wave = __builtin_amdgcn_readfirstlane(F.tid >> 6); F.G = gridDim.x; F.ws = args.ws;
    volatile LAS unsigned* MISC = (volatile LAS unsigned*)(F.lds + MISC_OFF);
    if (F.tid < 16) MISC[F.tid] = 0u;
    __syncthreads();
    unsigned* ctl = (unsigned*)(F.ws + WS_CTL);
    const int lo = args.ph_lo, hi = args.ph_hi; const bool multi = (hi - lo) > 1;
    XcdBarrier bar; bar.bar = ctl + CW_BAR; bar.x = 0; bar.st = MISC + 8;
    if (multi) bar = xcd_barrier_post(ctl + CW_BAR, MISC + 8);
#define IN(k) (lo <= (k) && (k) < hi)
#define SEAM(k) do { if (IN(k) && IN((k) + 1)) xcd_barrier(bar); } while (0)
    unsigned char* ws = F.ws;
    const float* x = args.in[0];
    float* MOD = (float*)(ws + WS_MOD);
    bf16* Hb = (bf16*)(ws + WS_H); float* ZF = (float*)(ws + WS_ZF); bf16* ZB = (bf16*)(ws + WS_ZB);
    bf16* CQN = (bf16*)(ws + WS_CQN); bf16* CKVN = (bf16*)(ws + WS_CKVN); bf16* KIDX = (bf16*)(ws + WS_KIDX);
    bf16* QLAT = (bf16*)(ws + WS_QLAT); bf16* QIDX = (bf16*)(ws + WS_QIDX); bf16* AO = (bf16*)(ws + WS_AO);
    float* X1 = (float*)(ws + WS_X1); float* X2 = (float*)(ws + WS_X2);
    float* GA = (float*)(ws + WS_GATE + GATE_GA); float* GMX = (float*)(ws + WS_GATE + GATE_GMX); float* GB = (float*)(ws + WS_GATE + GATE_GB); float* MINS = (float*)(ws + WS_GATE + GATE_MINS);
    bf16* CT = (bf16*)(ws + WS_CT); float* NS = (float*)(ws + WS_NS);
    bf16* XS = (bf16*)(ws + WS_XS); bf16* ACT = (bf16*)(ws + WS_ACT); bf16* YS = (bf16*)(ws + WS_YS);
    int* EIDX = (int*)(ws + WS_RT + RT_EIDX); float* GATE = (float*)(ws + WS_RT + RT_GATE); int* RANK = (int*)(ws + WS_RT + RT_RANK); int* TOKPOS = (int*)(ws + WS_RT + RT_TOKPOS);
    float* ROWGATE = (float*)(ws + WS_RT + RT_ROWGATE); int* TILEE = (int*)(ws + WS_RT + RT_TILEE); int* NTp = (int*)(ws + WS_RT + RT_NT);

    if (EN(13) && IN(0)) { p0_prologue(F, args); }
    SEAM(0);
    for (int l = 0; l < 2; ++l) {
        const int pb = 1 + l * PH_PER_LAYER;
        const float* mod = MOD + (size_t)l * 4 * 12288;
        const float* xin = (l == 0) ? x : X2;
        if (EN(0) && IN(pb + 0)) { if (l == 0) norm_phase(F, x, args.in[4], mod + 2048, mod, Hb); }
        SEAM(pb + 0);
        if (EN(1) && IN(pb + 1)) { pg8::Gemm gm{Hb, (const bf16*)(ws + WS_WIN) + (size_t)l * NZ * D, T, NZ, D}; pg8::StaticOrder S; S.init(T, NZ, F.G, (int)blockIdx.x);
            EpiZ E{ZF, ZB}; pg8::gemm_phase<EpiZ, pg8::StaticOrder, true, true>(F.lds, gm, S, E); }
        SEAM(pb + 1);
        if (EN(2) && IN(pb + 2)) p3_phase(F, ZF, args.in[6] + l * 512, args.in[7] + l * 256, args.in[12] + l * 4, args.in[13] + l * 4, CQN, CKVN, KIDX, GA, GMX, GB, MINS);
        SEAM(pb + 2);
        if (EN(3) && IN(pb + 3)) { pg8::Gemm gm{CQN, (const bf16*)(ws + WS_WQ) + (size_t)l * 2560 * 512, T, 2560, 512}; pg8::StaticOrder S; S.init(T, 2560, F.G, (int)blockIdx.x);
            EpiQ E{QLAT, QIDX}; pg8::gemm_phase<EpiQ, pg8::StaticOrder, true, true>(F.lds, gm, S, E); }
        SEAM(pb + 3);
        if (EN(4) && IN(pb + 4)) m1_scan(F, ZB, GA, GMX, MINS, CT, NS);
        SEAM(pb + 4);
        if ((EN(5) || EN(15)) && IN(pb + 5)) { if (EN(14)) dsa_phase(F, QIDX, KIDX, ZF, QLAT, CKVN, AO); if (EN(15)) m3_out(F, ZB, GA, GMX, GB, MINS, CT, NS, args.in[14] + l * 1024, AO); }
        SEAM(pb + 5);
        if (EN(6) && IN(pb + 6)) { pg8::Gemm gm{AO, (const bf16*)(ws + WS_WOUT) + (size_t)l * 2048 * 3072, T, 2048, 3072}; pg8::StaticOrder S; S.init(T, 2048, F.G, (int)blockIdx.x);
            EpiRes E{xin, X1, mod + 2 * 2048}; pg8::gemm_phase<EpiRes, pg8::StaticOrder, true, true>(F.lds, gm, S, E); }
        SEAM(pb + 6);
        if (EN(7) && IN(pb + 7)) norm_phase(F, X1, args.in[16] + l * 2048, mod + 4 * 2048, mod + 3 * 2048, Hb);
        SEAM(pb + 7);
        if (EN(8) && IN(pb + 8)) router_phase(F, Hb, (const bf16*)(ws + WS_WR), args.in[18], (int*)(ctl + CW_ECNT) + l * 32, EIDX, GATE, RANK);
        SEAM(pb + 8);
        if (EN(9) && IN(pb + 9)) scatter_phase(F, Hb, (const int*)(ctl + CW_ECNT) + l * 32, EIDX, GATE, RANK, XS, TOKPOS, ROWGATE, TILEE, NTp);
        SEAM(pb + 9);
        if (EN(10) && IN(pb + 10)) { pg8::Gemm gm{XS, (const bf16*)(ws + WS_WGU) + (size_t)l * 32 * 1024 * 2048, MPAD, 32 * 1024, 2048}; MoeOrder S{TILEE, NTp[0], 4, F.G, (int)blockIdx.x};
            EpiGU E{ACT}; pg8::gemm_phase<EpiGU, MoeOrder, true, true>(F.lds, gm, S, E); }
        SEAM(pb + 10);
        if (EN(11) && IN(pb + 11)) { pg8::Gemm gm{ACT, (const bf16*)(ws + WS_WD) + (size_t)l * 32 * 2048 * 512, MPAD, 32 * 2048, 512}; MoeOrder S{TILEE, NTp[0], 8, F.G, (int)blockIdx.x};
            EpiDN E{YS, ROWGATE}; pg8::gemm_phase<EpiDN, MoeOrder, true, true>(F.lds, gm, S, E); }
        SEAM(pb + 11);
        if (EN(12) && IN(pb + 12)) { const float* mod1 = MOD + (size_t)4 * 12288;
            if (l == 0) combine_phase(F, 0, X1, mod + 5 * 2048, YS, TOKPOS, X2, args.in[4] + 2048, mod1 + 2048, mod1, Hb, nullptr);
            else combine_phase(F, 1, X1, mod + 5 * 2048, YS, TOKPOS, nullptr, args.in[21], nullptr, nullptr, nullptr, args.out); }
        SEAM(pb + 12);
    }
#undef IN
#undef SEAM
}

#ifndef MK_N_LAUNCHES
#define MK_N_LAUNCHES 27
#endif
extern "C" void kernel_launch(void* const* d_in, const int* in_sizes, int n_in, void* d_out, int out_size, void* d_ws, size_t ws_size, hipStream_t stream) {
    static int grid = 0;
    if (grid == 0) {
        if (n_in != 22 || out_size != T * D || ws_size < WS_END) { fprintf(stderr, "kernel_launch: unexpected problem (n_in %d out %d ws %zu)\n", n_in, out_size, ws_size); grid = -1; return; }
        int dev = 0, cus = 0, per_cu = 0;
        if (hipGetDevice(&dev) != hipSuccess || hipDeviceGetAttribute(&cus, hipDeviceAttributeMultiprocessorCount, dev) != hipSuccess) { grid = -1; return; }
        bool ok = true;
#define SETATTR(K) ok = ok && (hipFuncSetAttribute((const void*)mk_fwd<K>, hipFuncAttributeMaxDynamicSharedMemorySize, LDS_BYTES) == hipSuccess)
#if MK_N_LAUNCHES == 1
        SETATTR(-1);
#else
        SETATTR(14);
#endif
        SETATTR(0); SETATTR(1); SETATTR(2); SETATTR(3); SETATTR(4); SETATTR(5); SETATTR(6); SETATTR(7); SETATTR(8); SETATTR(9); SETATTR(10); SETATTR(11); SETATTR(12); SETATTR(13);
#undef SETATTR
        if (!ok) { fprintf(stderr, "kernel_launch: hipFuncSetAttribute failed\n"); grid = -1; return; }
        if (hipOccupancyMaxActiveBlocksPerMultiprocessor(&per_cu, (const void*)mk_fwd<(MK_N_LAUNCHES == 1 ? -1 : 1)>, NTHR, LDS_BYTES) != hipSuccess || per_cu < 1) fprintf(stderr, "kernel_launch: occupancy query says %d\n", per_cu);
        (void)hipGetLastError();
        grid = cus;
    }
    if (grid < 0) return;
    (void)hipMemsetAsync((char*)d_ws + WS_CTL, 0, CTL_ZERO_BYTES, stream);
    Args a{};
    for (int i = 0; i < 22; ++i) a.in[i] = (const float*)d_in[i];
    a.out = (float*)d_out; a.ws = (unsigned char*)d_ws;
#if MK_N_LAUNCHES == 1
    { a.ph_lo = 0; a.ph_hi = N_PHASES; hipLaunchKernelGGL(mk_fwd<-1>, dim3(grid), dim3(NTHR), LDS_BYTES, stream, a); }
#else
    {
        for (int p = 0; p < N_PHASES; ++p) {
            if (p == 1 + PH_PER_LAYER) continue;
            a.ph_lo = p; a.ph_hi = p + 1;
            const int j = (p == 0) ? 13 : (p - 1) % PH_PER_LAYER;
#define LCASE(K) case K: hipLaunchKernelGGL(mk_fwd<K>, dim3(grid), dim3(NTHR), LDS_BYTES, stream, a); break
            if (j == 5) hipLaunchKernelGGL(mk_fwd<14>, dim3(grid), dim3(NTHR), LDS_BYTES, stream, a);
            switch (j) { LCASE(0); LCASE(1); LCASE(2); LCASE(3); LCASE(4); LCASE(5); LCASE(6); LCASE(7); LCASE(8); LCASE(9); LCASE(10); LCASE(11); LCASE(12); LCASE(13); }
#undef LCASE
        }
    }
#endif
}
```

```cpp
#include <hip/hip_runtime.h>
#include <cstdio>
#include <cstdint>

#define LAS __attribute__((address_space(3)))
#define GAS __attribute__((address_space(1)))
typedef unsigned short bf16;
typedef short bf16x8 __attribute__((ext_vector_type(8)));
typedef float f32x4 __attribute__((ext_vector_type(4)));
typedef float f32x16 __attribute__((ext_vector_type(16)));
typedef unsigned v4u __attribute__((ext_vector_type(4)));
typedef unsigned v2u __attribute__((ext_vector_type(2)));
#define LDS_WAIT() asm volatile("s_waitcnt lgkmcnt(0)" ::: "memory")
#define VM_WAIT() asm volatile("s_waitcnt vmcnt(0)" ::: "memory")

__device__ __forceinline__ unsigned cvt_pk_bf16(float lo, float hi) { unsigned r; asm volatile("v_cvt_pk_bf16_f32 %0, %1, %2" : "=v"(r) : "v"(lo), "v"(hi)); return r; }
__device__ __forceinline__ float bf_lo(unsigned u) { return __builtin_bit_cast(float, u << 16); }
__device__ __forceinline__ float bf_hi(unsigned u) { return __builtin_bit_cast(float, u & 0xffff0000u); }
__device__ __forceinline__ float wave_sum(float v) {
#pragma unroll
    for (int o = 1; o < 64; o <<= 1) v += __shfl_xor(v, o);
    return v;
}

namespace pg8 {
typedef unsigned short bf16_t;
constexpr int BM = 256, BK = 64, HALF = 128, HTB = HALF * BK * 2, STAGE_BYTES = 8 * HTB, NXCD = 8, WGM = 8;
__host__ __device__ __forceinline__ int lds_byte(int r, int c) { const int st = (r >> 4) * 2 + (c >> 5), rr = r & 15, cc = c & 31, ob = rr * 64 + cc * 2; return st * 1024 + (ob ^ (((ob >> 9) & 1) << 5)); }
__host__ __device__ __forceinline__ void stage_rc(int b, int& R, int& C) { const int st = b / 1024, sb = b % 1024, swz = sb ^ (((sb >> 9) & 1) << 5); R = (st >> 1) * 16 + swz / 64; C = (st & 1) * 32 + (swz % 64) / 2; }
__host__ __device__ __forceinline__ int perm32(int rho) { const int n = rho >> 4, i = rho & 15; return 8 * (i >> 2) + 4 * n + (i & 3); }
struct Unit { int pm, pn; };
struct Gemm { const bf16_t* A; const bf16_t* Bt; int M, N, K; };
struct StaticOrder {
    int nM, nN, nwg, G, c;
    __host__ __device__ void init(int M, int N, int G_, int c_) { nM = M / BM; nN = N / BM; nwg = nM * nN; G = G_; c = c_; }
    __host__ __device__ bool next(int i, Unit& u) const {
        const long L = (long)i * G + c; if (L >= nwg) return false;
        int wgid = (int)L; { const int q = nwg / NXCD, r = nwg % NXCD, xcd = wgid % NXCD, off = wgid / NXCD; wgid = (xcd < r ? xcd * (q + 1) : r * (q + 1) + (xcd - r) * q) + off; }
        const int nig = WGM * nN, gid = wgid / nig, fm = gid * WGM, gsz = (nM - fm) < WGM ? (nM - fm) : WGM;
        u.pm = fm + ((wgid % nig) % gsz); u.pn = (wgid % nig) / gsz; return true;
    }
    __device__ __forceinline__ void a_ready(const Unit&) const {}
    __device__ __forceinline__ void done(const Unit&) const {}
};
template <class Epi, class Sched, bool ALIGN_EPI = false, bool SP2 = false>
__device__ __forceinline__ void gemm_phase(LAS unsigned char* lds, const Gemm g, const Sched& S, const Epi& E, const int wave_id) {
    int lane; asm volatile("v_mbcnt_lo_u32_b32 %0, -1, 0\n\tv_mbcnt_hi_u32_b32 %0, -1, %0" : "=v"(lane));
    const int wid = wave_id, tid = wid * 64 + lane;
    const int wr = wid >> 2, wc = wid & 3, fr = lane & 15, fq = lane >> 4;
    const int K = g.K, nt = K / BK;
    unsigned voffA[2], voffB[2];
#pragma unroll
    for (int i = 0; i < 2; ++i) { int R, C; stage_rc(tid * 16 + i * 8192, R, C); const int Rb = Epi::PERM ? ((R & ~31) + perm32(R & 31)) : R;
        voffA[i] = (unsigned)(R * K + C) * 2u; voffB[i] = (unsigned)(Rb * K + C) * 2u; }
    const size_t kstep = (size_t)(BK * 2);
    const size_t hstep = (size_t)HALF * K * 2;
    const size_t tstep = 2 * hstep;
    const unsigned ldsw = (unsigned)wid * 1024u;
    const int aoff = lds_byte(wr * 64 + fr, fq * 8), boff = lds_byte(wc * 32 + fr, fq * 8);
#define PG8_SA(b, h) (((b) * 2 + (h)) * HTB)
#define PG8_SB(b, h) ((4 + (b) * 2 + (h)) * HTB)
#define PG8_STAGE(bufoff, gbase, voff) do { _Pragma("unroll") for (int _i = 0; _i < 2; ++_i) \
        __builtin_amdgcn_global_load_lds((const unsigned*)((const char*)(gbase) + (voff)[_i]), (LAS unsigned*)(lds + (bufoff) + ldsw + _i * 8192), 16, 0, 0); } while (0)
#define PG8_LDA(dst, b, h) do { _Pragma("unroll") for (int m = 0; m < 4; ++m) _Pragma("unroll") for (int k = 0; k < 2; ++k) dst[m][k] = *(const LAS bf16x8*)(lds + PG8_SA(b, h) + aoff + m * 2048 + k * 1024); } while (0)
#define PG8_LDB(dst, b, h) do { _Pragma("unroll") for (int n = 0; n < 2; ++n) _Pragma("unroll") for (int k = 0; k < 2; ++k) dst[n][k] = *(const LAS bf16x8*)(lds + PG8_SB(b, h) + boff + n * 2048 + k * 1024); } while (0)
#define PG8_MMA(ai, bj, At, Bt) do { __builtin_amdgcn_s_setprio(1); _Pragma("unroll") for (int m = 0; m < 4; ++m) _Pragma("unroll") for (int n = 0; n < 2; ++n) _Pragma("unroll") for (int k = 0; k < 2; ++k) \
        acc[ai][bj][m][n] = __builtin_amdgcn_mfma_f32_16x16x32_bf16(Bt[n][k], At[m][k], acc[ai][bj][m][n], 0, 0, 0); __builtin_amdgcn_s_setprio(0); } while (0)
#define PG8_WAIT_V(n) asm volatile("s_waitcnt vmcnt(" #n ")" ::: "memory")
#define PG8_WAIT_L(n) asm volatile("s_waitcnt lgkmcnt(" #n ")" ::: "memory")
#define PG8_BAR __builtin_amdgcn_s_barrier()
#define PG8_SCHED __builtin_amdgcn_sched_barrier(0)
    Unit cur, nxt; int ui = 0;
    if (!S.next(0, cur)) return;
    f32x4 acc[2][2][4][2];
#pragma unroll
    for (int a = 0; a < 2; ++a)
#pragma unroll
        for (int b = 0; b < 2; ++b)
#pragma unroll
            for (int m = 0; m < 4; ++m)
#pragma unroll
                for (int n = 0; n < 2; ++n) acc[a][b][m][n] = (f32x4){0.f, 0.f, 0.f, 0.f};
    bf16x8 At[4][2], B0[2][2], B1[2][2];
    const char* cA = (const char*)g.A + (size_t)cur.pm * tstep; const char* cB = (const char*)g.Bt + (size_t)cur.pn * tstep;
    S.a_ready(cur);
    if constexpr (SP2) {
        PG8_STAGE(PG8_SB(0, 0), cB, voffB); PG8_STAGE(PG8_SB(0, 1), cB + hstep, voffB); PG8_STAGE(PG8_SA(0, 0), cA, voffA); PG8_STAGE(PG8_SA(0, 1), cA + hstep, voffA);
        if (wr == 1) PG8_BAR;
        PG8_WAIT_V(2); PG8_BAR;
        PG8_STAGE(PG8_SB(1, 0), cB + kstep, voffB); PG8_STAGE(PG8_SA(1, 0), cA + kstep, voffA); PG8_STAGE(PG8_SB(1, 1), cB + hstep + kstep, voffB);
        PG8_WAIT_V(6); PG8_BAR;
    } else {
        PG8_STAGE(PG8_SB(0, 0), cB, voffB); PG8_STAGE(PG8_SA(0, 0), cA, voffA); PG8_STAGE(PG8_SB(0, 1), cB + hstep, voffB); PG8_STAGE(PG8_SA(0, 1), cA + hstep, voffA);
        if (wr == 1) PG8_BAR;
        PG8_WAIT_V(4); PG8_BAR;
        PG8_STAGE(PG8_SB(1, 0), cB + kstep, voffB); PG8_STAGE(PG8_SA(1, 0), cA + kstep, voffA); PG8_STAGE(PG8_SB(1, 1), cB + hstep + kstep, voffB);
        PG8_WAIT_V(6); PG8_BAR;
    }
    for (;;) {
        const bool has_next = S.next(ui + 1, nxt);
        const char* nA = has_next ? (const char*)g.A + (size_t)nxt.pm * tstep : cA; const char* nB = has_next ? (const char*)g.Bt + (size_t)nxt.pn * tstep : cB;
        for (int t = 0; t < nt; t += 2) {
            const bool last = (t == nt - 2);
            const char* a1 = cA + (size_t)(t + 1) * kstep;
            const char* a2 = last ? nA : cA + (size_t)(t + 2) * kstep; const char* b2 = last ? nB : cB + (size_t)(t + 2) * kstep;
            const char* a3 = a2 + kstep; const char* b3 = b2 + kstep;
            if (last && has_next) S.a_ready(nxt);
            if constexpr (SP2) {
            PG8_LDB(B0, 0, 0); PG8_LDB(B1, 0, 1); PG8_SCHED; PG8_LDA(At, 0, 0); PG8_STAGE(PG8_SA(1, 1), a1 + hstep, voffA);
            PG8_WAIT_V(8); PG8_WAIT_L(0); PG8_BAR; PG8_MMA(0, 0, At, B0); PG8_MMA(0, 1, At, B1); PG8_BAR; PG8_SCHED;
            PG8_LDA(At, 0, 1); PG8_STAGE(PG8_SB(0, 0), b2, voffB); PG8_STAGE(PG8_SB(0, 1), b2 + hstep, voffB); PG8_STAGE(PG8_SA(0, 0), a2, voffA);
            PG8_WAIT_V(8); PG8_WAIT_L(0); PG8_BAR; PG8_MMA(1, 0, At, B0); PG8_MMA(1, 1, At, B1); PG8_BAR; PG8_SCHED;
            PG8_LDB(B0, 1, 0); PG8_LDB(B1, 1, 1); PG8_SCHED; PG8_LDA(At, 1, 0); PG8_STAGE(PG8_SA(0, 1), a2 + hstep, voffA);
            PG8_WAIT_V(8); PG8_WAIT_L(0); PG8_BAR; PG8_MMA(0, 0, At, B0); PG8_MMA(0, 1, At, B1); PG8_BAR; PG8_SCHED;
            PG8_LDA(At, 1, 1); PG8_STAGE(PG8_SB(1, 0), b3, voffB); PG8_STAGE(PG8_SB(1, 1), b3 + hstep, voffB); PG8_STAGE(PG8_SA(1, 0), a3, voffA);
            PG8_WAIT_V(8); PG8_WAIT_L(0); PG8_BAR; PG8_MMA(1, 0, At, B0); PG8_MMA(1, 1, At, B1); PG8_BAR; PG8_SCHED;
            } else {
            PG8_LDB(B0, 0, 0); PG8_SCHED; PG8_LDA(At, 0, 0); PG8_STAGE(PG8_SA(1, 1), a1 + hstep, voffA);
            PG8_WAIT_L(8); PG8_BAR; PG8_WAIT_L(0); PG8_MMA(0, 0, At, B0); PG8_BAR; PG8_SCHED;
            PG8_LDB(B1, 0, 1); PG8_STAGE(PG8_SB(0, 0), b2, voffB);
            PG8_BAR; PG8_WAIT_L(0); PG8_MMA(0, 1, At, B1); PG8_BAR;
            PG8_LDA(At, 0, 1); PG8_STAGE(PG8_SA(0, 0), a2, voffA);
            PG8_BAR; PG8_WAIT_L(0); PG8_MMA(1, 0, At, B0); PG8_BAR; PG8_SCHED;
            PG8_STAGE(PG8_SB(0, 1), b2 + hstep, voffB);
            PG8_WAIT_V(6); PG8_BAR; PG8_MMA(1, 1, At, B1); PG8_BAR;
            PG8_LDB(B0, 1, 0); PG8_SCHED; PG8_LDA(At, 1, 0); PG8_STAGE(PG8_SA(0, 1), a2 + hstep, voffA);
            PG8_WAIT_L(8); PG8_BAR; PG8_WAIT_L(0); PG8_MMA(0, 0, At, B0); PG8_BAR; PG8_SCHED;
            PG8_LDB(B1, 1, 1); PG8_STAGE(PG8_SB(1, 0), b3, voffB);
            PG8_BAR; PG8_WAIT_L(0); PG8_MMA(0, 1, At, B1); PG8_BAR;
            PG8_LDA(At, 1, 1); PG8_STAGE(PG8_SA(1, 0), a3, voffA);
            PG8_BAR; PG8_WAIT_L(0); PG8_MMA(1, 0, At, B0); PG8_BAR; PG8_SCHED;
            PG8_STAGE(PG8_SB(1, 1), b3 + hstep, voffB);
            PG8_WAIT_V(6); PG8_BAR; PG8_MMA(1, 1, At, B1); PG8_BAR;
            }
        }
        if constexpr (ALIGN_EPI) { if (wr == 0) PG8_BAR; }
        E(acc, cur, wr, wc, fr, fq); S.done(cur);
        if (!has_next) break;
#pragma unroll
        for (int a = 0; a < 2; ++a)
#pragma unroll
            for (int b = 0; b < 2; ++b)
#pragma unroll
                for (int m = 0; m < 4; ++m)
#pragma unroll
                    for (int n = 0; n < 2; ++n) acc[a][b][m][n] = (f32x4){0.f, 0.f, 0.f, 0.f};
        cur = nxt; cA = nA; cB = nB; ++ui;
        if constexpr (ALIGN_EPI) { if (wr == 1) PG8_BAR; }
    }
    PG8_WAIT_V(0);
    if constexpr (!ALIGN_EPI) { if (wr == 0) PG8_BAR; }
    PG8_BAR;
#undef PG8_SA
#undef PG8_SB
#undef PG8_STAGE
#undef PG8_LDA
#undef PG8_LDB
#undef PG8_MMA
#undef PG8_WAIT_V
#undef PG8_WAIT_L
#undef PG8_BAR
#undef PG8_SCHED
}
}

#define XB_TMO      128
#define XB_XCNT(j)  (256  + 64 * (j))
#define XB_XSUB(j)  (1280 + 64 * (j))
#define XB_XGEN(j)  (2304 + 64 * (j))
#define XB_TOP      3328
#define XB_TOPGEN   3392
#define XCD_BAR_WORDS 3456
#define XB_SPIN_CAP (1u << 18)
__device__ __forceinline__ unsigned xb_ld(unsigned* p)              { return __hip_atomic_load(p, __ATOMIC_RELAXED, __HIP_MEMORY_SCOPE_AGENT); }
__device__ __forceinline__ unsigned xb_add(unsigned* p, unsigned v) { return __hip_atomic_fetch_add(p, v, __ATOMIC_RELAXED, __HIP_MEMORY_SCOPE_AGENT); }
__device__ __forceinline__ unsigned xb_xcc_id() { return (unsigned)__builtin_amdgcn_s_getreg((3 << 11) | 20) & 0xFu; }
#define XB_SPIN(cond, bar) do { unsigned _sp = 0; while (cond) { __builtin_amdgcn_s_sleep(1); \
    if ((++_sp & 255u) == 0u) { if (xb_ld(&(bar)[XB_TMO])) break; if (_sp > XB_SPIN_CAP) { atomicAdd(&(bar)[XB_TMO], 1u); break; } } } } while (0)
struct XcdBarrier { unsigned* bar; unsigned x; volatile LAS unsigned* st; };
__device__ __forceinline__ XcdBarrier xcd_barrier_post(unsigned* bar, volatile LAS unsigned* st) {
    XcdBarrier b; b.bar = bar; b.x = xb_xcc_id(); b.st = st;
    if (threadIdx.x == 0) (void)xb_add(&bar[XB_XCNT(b.x)], 1u);
    return b;
}
__device__ __forceinline__ void xcd_barrier_complete(unsigned* bar, unsigned x, unsigned& nloc, unsigned& nx) {
    const unsigned G = gridDim.x * gridDim.y * gridDim.z;
    unsigned sum, cnt, mine, sp = 0u;
    for (;;) {
        sum = 0u; cnt = 0u; mine = 0u;
#pragma unroll
        for (unsigned j = 0; j < 16; ++j) { const unsigned c = xb_ld(&bar[XB_XCNT(j)]); sum += c; cnt += (c > 0u) ? 1u : 0u; mine = (j == x) ? c : mine; }
        if (sum == G) break;
        __builtin_amdgcn_s_sleep(1);
        if ((++sp & 255u) == 0u) { if (xb_ld(&bar[XB_TMO])) break; if (sp > XB_SPIN_CAP) { atomicAdd(&bar[XB_TMO], 1u); break; } }
    }
    nloc = mine > 0u ? mine : 1u; nx = cnt > 0u ? cnt : 1u;
}
__device__ __forceinline__ void xcd_barrier(const XcdBarrier& b) {
    asm volatile("s_waitcnt vmcnt(0)" ::: "memory");
    __syncthreads();
    if (threadIdx.x == 0) {
        unsigned* bar = b.bar;
        __builtin_amdgcn_s_waitcnt(0);
        unsigned nloc = b.st[0], nx = b.st[1];
        if (nloc == 0u) { xcd_barrier_complete(bar, b.x, nloc, nx); b.st[0] = nloc; b.st[1] = nx; }
        const unsigned old = xb_add(&bar[XB_XSUB(b.x)], 1u);
        const unsigned gen = old / nloc;
        if (old + 1u == (gen + 1u) * nloc) {
            __builtin_amdgcn_fence(__ATOMIC_RELEASE, "agent");
            asm volatile("s_waitcnt vmcnt(0)" ::: "memory");
            const unsigned og = xb_add(&bar[XB_TOP], 1u);
            const unsigned tg = og / nx;
            if (og + 1u == (tg + 1u) * nx) xb_add(&bar[XB_TOPGEN], 1u);
            else XB_SPIN(xb_ld(&bar[XB_TOPGEN]) == tg, bar);
            __builtin_amdgcn_fence(__ATOMIC_ACQUIRE, "agent");
            xb_add(&bar[XB_XGEN(b.x)], 1u);
            asm volatile("s_waitcnt vmcnt(0)" ::: "memory");
        } else {
            XB_SPIN(xb_ld(&bar[XB_XGEN(b.x)]) == gen, bar);
            __builtin_amdgcn_fence(__ATOMIC_ACQUIRE, "agent");
            asm volatile("s_waitcnt vmcnt(0)" ::: "memory");
        }
    }
    __syncthreads();
}

constexpr int T = 16384, SEQ = 4096, NB = 4, D = 2048, DIN = 3920, NZ = 4096;
constexpr int NE = 32;
constexpr int MPAD = 40960;
constexpr float EPS = 1e-6f;
constexpr int NWAVES = 8, NTHR = 512;
constexpr size_t MiB = 1u << 20;
constexpr size_t WS_CTL = 0, CTL_ZERO_BYTES = 1 * MiB;
constexpr int CW_BAR = 4096;
constexpr int CW_ECNT = 8192;
constexpr size_t WS_MOD = 512 * 1024;
constexpr size_t WS_WIN = 2 * MiB, WS_WQ = 34 * MiB, WS_WOUT = 40 * MiB, WS_WR = 64 * MiB, WS_WGU = 66 * MiB, WS_WD = 322 * MiB;
constexpr size_t WS_H = 450 * MiB, WS_ZF = 514 * MiB, WS_ZB = 578 * MiB, WS_CQN = 674 * MiB, WS_CKVN = 690 * MiB, WS_KIDX = 698 * MiB;
constexpr size_t WS_QLAT = 700 * MiB, WS_QIDX = 764 * MiB, WS_AO = 780 * MiB, WS_X1 = 876 * MiB, WS_X2 = 1004 * MiB;
constexpr size_t WS_GATE = 1132 * MiB, WS_CT = 1134 * MiB, WS_NS = 1198 * MiB, WS_XS = 1200 * MiB, WS_ACT = 1360 * MiB, WS_YS = 1400 * MiB, WS_RT = 1560 * MiB, WS_END = 1564 * MiB;
constexpr size_t GATE_GA = 0, GATE_GMX = 262144, GATE_GB = 524288, GATE_MINS = 786432;
constexpr size_t RT_EIDX = 0, RT_GATE = 131072, RT_RANK = 262144, RT_TOKPOS = 393216, RT_ROWGATE = 524288, RT_TILEE = 524288 + 163840, RT_NT = RT_TILEE + 1024;
constexpr int LDS_BYTES = 147456;
constexpr int MISC_OFF = 140 * 1024;

struct Args { const float* in[22]; float* out; unsigned char* ws; int ph_lo, ph_hi; };

struct Frame {
    LAS unsigned char* lds;
    int tid, lane, wave, G;
    unsigned char* ws;
    const char __attribute__((address_space(4)))* ka;
};

__device__ __forceinline__ int rowmap_win(int n) {
    if (n < 768) return n;
    if (n < 832) return 3840 + (n - 768);
    if (n < 840) return 3904 + (n - 832);
    if (n < 3912) return 768 + (n - 840);
    return 3912 + (n - 3912);
}
__device__ __forceinline__ int rowmap_gu(int n) { return n < 512 ? ((n >> 7) * 256 + (n & 127)) : (((n - 512) >> 7) * 256 + 128 + ((n - 512) & 127)); }

template <int RM>
__device__ __forceinline__ void tr_item(const float* __restrict__ W, int ldw, int nmax, int k0, int n0, bf16* WT, int ldt, int kdst0, LAS float* scr, int lane) {
    const int nn = lane & 31; const bool okn = (n0 + nn) < nmax;
#pragma unroll 8
    for (int i = 0; i < 32; ++i) { const int kk = 2 * i + (lane >> 5); scr[kk * 33 + nn] = okn ? W[(size_t)(k0 + kk) * ldw + n0 + nn] : 0.f; }
    LDS_WAIT(); asm volatile("" ::: "memory");
    const int c = lane & 7;
#pragma unroll
    for (int j = 0; j < 4; ++j) { const int n = (lane >> 3) + 8 * j; const LAS float* s = scr + (8 * c) * 33 + n;
        v4u o; o.x = cvt_pk_bf16(s[0 * 33], s[1 * 33]); o.y = cvt_pk_bf16(s[2 * 33], s[3 * 33]); o.z = cvt_pk_bf16(s[4 * 33], s[5 * 33]); o.w = cvt_pk_bf16(s[6 * 33], s[7 * 33]);
        const int ng = n0 + n; const int row = RM == 1 ? rowmap_win(ng) : (RM == 2 ? rowmap_gu(ng) : ng);
        if (ng < nmax) *(v4u*)(WT + (size_t)row * ldt + kdst0 + k0 + 8 * c) = o; }
    LDS_WAIT(); asm volatile("" ::: "memory");
}

template <bool QT>
__device__ __forceinline__ void fold_item(const float* __restrict__ P, int ps, const float* __restrict__ Q, int qs, bf16* dst, int ldd, float scale, LAS float* Ps, LAS float* Qs, int tid) {
    __syncthreads();
#pragma unroll 4
    for (int it = 0; it < 16; ++it) { const int idx = it * 512 + tid; const int r = idx >> 7, d = idx & 127; Ps[r * 129 + d] = P[(size_t)r * ps + d]; }
    if (!QT) {
#pragma unroll 4
        for (int it = 0; it < 16; ++it) { const int idx = it * 512 + tid; const int r = idx >> 7, d = idx & 127; Qs[r * 129 + d] = Q[(size_t)r * qs + d]; }
    } else {
#pragma unroll 4
        for (int it = 0; it < 16; ++it) { const int idx = it * 512 + tid; const int d = idx >> 6, j = idx & 63; Qs[j * 129 + d] = Q[(size_t)d * qs + j]; }
    }
    __syncthreads();
    const int i = tid & 63, j0 = (tid >> 6) * 8;
    float a[8];
#pragma unroll
    for (int jj = 0; jj < 8; ++jj) a[jj] = 0.f;
#pragma unroll 4
    for (int d = 0; d < 128; ++d) { const float p = Ps[i * 129 + d];
#pragma unroll
        for (int jj = 0; jj < 8; ++jj) a[jj] += p * Qs[(j0 + jj) * 129 + d]; }
#pragma unroll
    for (int jj = 0; jj < 8; ++jj) { const unsigned u = cvt_pk_bf16(a[jj] * scale, 0.f); dst[(size_t)(j0 + jj) * ldd + i] = (bf16)(u & 0xffffu); }
}

#define AIN(i) (*(const float* const __attribute__((address_space(4)))*)(F.ka + 8 * (i)))
__device__ __forceinline__ void p0_prologue(Frame& F) {
    const float* c = AIN(1); const float* ada_w = AIN(2); const float* ada_b = AIN(3);
    const float* w_in = AIN(5); const float* w_uq = AIN(8); const float* w_uk = AIN(9); const float* w_uv = AIN(10); const float* w_qidx = AIN(11);
    const float* w_out = AIN(15); const float* router_w = AIN(17); const float* w_gu = AIN(19); const float* w_dn = AIN(20);
    bf16* WIN = (bf16*)(F.ws + WS_WIN); bf16* WQ = (bf16*)(F.ws + WS_WQ); bf16* WOUT = (bf16*)(F.ws + WS_WOUT); bf16* WR = (bf16*)(F.ws + WS_WR);
    bf16* WGU = (bf16*)(F.ws + WS_WGU); bf16* WD = (bf16*)(F.ws + WS_WD); float* MOD = (float*)(F.ws + WS_MOD);
    const int gw = blockIdx.x * NWAVES + F.wave, NGW = F.G * NWAVES;
    {
        LAS float* cs = (LAS float*)(F.lds);
        for (int i = F.tid; i < NB * D; i += NTHR) { const float v = c[i]; cs[i] = v / (1.f + __expf(-v)); }
        __syncthreads();
        constexpr int NCG = 12288 / 128, NTASK = 2 * NCG;
        typedef float f32x2 __attribute__((ext_vector_type(2)));
        LAS float* red = (LAS float*)(F.lds + 32768);
        for (int task = blockIdx.x; task < NTASK; task += F.G) {
            const int cg = task % NCG, l = task / NCG;
            const int n = cg * 128 + F.lane * 2, k0 = F.wave * 256;
            const float* wp = ada_w + ((size_t)l * D + k0) * 12288 + n;
            f32x2 acc[4];
#pragma unroll
            for (int b = 0; b < 4; ++b) acc[b] = (f32x2){0.f, 0.f};
#pragma unroll 8
            for (int k = 0; k < 256; ++k) { const f32x2 w = *(const f32x2*)(wp + (size_t)k * 12288);
#pragma unroll
                for (int b = 0; b < 4; ++b) acc[b] += w * cs[b * D + k0 + k]; }
            __syncthreads();
#pragma unroll
            for (int b = 0; b < 4; ++b) { red[(F.wave * 4 + b) * 128 + F.lane * 2] = acc[b].x; red[(F.wave * 4 + b) * 128 + F.lane * 2 + 1] = acc[b].y; }
            __syncthreads();
            { const int b = F.tid >> 7, c = F.tid & 127; float sum = ada_b[(size_t)l * 12288 + cg * 128 + c];
#pragma unroll
              for (int w8 = 0; w8 < 8; ++w8) sum += red[(w8 * 4 + b) * 128 + c];
              MOD[((size_t)l * 4 + b) * 12288 + cg * 128 + c] = sum; }
        }
        __syncthreads();
    }
    {
        LAS float* Ps = (LAS float*)(F.lds); LAS float* Qs = Ps + 64 * 129;
        constexpr int NQL = 2 * 8 * 8 * 4, NOV = 2 * 8 * 4 * 32;
        for (int it = blockIdx.x; it < NQL + NOV; it += F.G) {
            if (it < NQL) { const int jt = it & 3, itl = (it >> 2) & 7, h = (it >> 5) & 7, l = it >> 8;
                fold_item<false>(w_uq + (size_t)l * 512 * 1024 + (size_t)(itl * 64) * 1024 + h * 128, 1024, w_uk + (size_t)l * 256 * 1024 + (size_t)(jt * 64) * 1024 + h * 128, 1024,
                                 WQ + (size_t)l * 2560 * 512 + (size_t)(h * 256 + jt * 64) * 512 + itl * 64, 512, 0.08838834764831845f * 1.4426950408889634f, Ps, Qs, F.tid);
            } else { const int r = it - NQL; const int jt = r & 31, itl = (r >> 5) & 3, h = (r >> 7) & 7, l = r >> 10;
                fold_item<true>(w_uv + (size_t)l * 256 * 1024 + (size_t)(itl * 64) * 1024 + h * 128, 1024, w_out + (size_t)l * 2048 * 2048 + (size_t)(h * 128) * 2048 + jt * 64, 2048,
                                WOUT + (size_t)l * 2048 * 3072 + (size_t)(jt * 64) * 3072 + h * 256 + itl * 64, 3072, 1.0f, Ps, Qs, F.tid);
            }
        }
        __syncthreads();
    }
    {
        LAS float* scr = (LAS float*)(F.lds + F.wave * 8704);
        constexpr int I_WIN = 32 * 123, I_QI = 8 * 16, I_WO = 16 * 64, I_R = 32 * 1, I_GU = 32 * 32, I_DN = 8 * 64;
        constexpr int NIT = 2 * I_WIN + 2 * I_QI + 2 * I_WO + I_R + 64 * I_GU + 64 * I_DN;
        for (int it = gw; it < NIT; it += NGW) {
            int r = it;
            if (r < 2 * I_WIN) { const int l = r / I_WIN; r %= I_WIN; const int kb = r / 123, nb = r % 123;
                tr_item<1>(w_in + (size_t)l * D * DIN, DIN, DIN, kb * 64, nb * 32, WIN + (size_t)l * NZ * D, D, 0, scr, F.lane); continue; } r -= 2 * I_WIN;
            if (r < 2 * I_QI) { const int l = r / I_QI; r %= I_QI; const int kb = r / 16, nb = r % 16;
                tr_item<0>(w_qidx + (size_t)l * 512 * 512, 512, 512, kb * 64, nb * 32, WQ + (size_t)l * 2560 * 512 + (size_t)2048 * 512, 512, 0, scr, F.lane); continue; } r -= 2 * I_QI;
            if (r < 2 * I_WO) { const int l = r / I_WO; r %= I_WO; const int kb = r / 64, nb = r % 64;
                tr_item<0>(w_out + (size_t)l * 2048 * 2048 + (size_t)1024 * 2048, 2048, 2048, kb * 64, nb * 32, WOUT + (size_t)l * 2048 * 3072, 3072, 2048, scr, F.lane); continue; } r -= 2 * I_WO;
            if (r < I_R) { tr_item<0>(router_w, 32, 32, r * 64, 0, WR, 2048, 0, scr, F.lane); continue; } r -= I_R;
            if (r < 64 * I_GU) { const int le = r / I_GU; r %= I_GU; const int kb = r / 32, nb = r % 32;
                tr_item<2>(w_gu + (size_t)le * 2048 * 1024, 1024, 1024, kb * 64, nb * 32, WGU + (size_t)le * 1024 * 2048, 2048, 0, scr, F.lane); continue; } r -= 64 * I_GU;
            { const int le = r / I_DN; r %= I_DN; const int kb = r / 64, nb = r % 64;
                tr_item<0>(w_dn + (size_t)le * 512 * 2048, 2048, 2048, kb * 64, nb * 32, WD + (size_t)le * 2048 * 512, 512, 0, scr, F.lane); }
        }
    }
}

__device__ __forceinline__ void norm_phase(Frame& F, const float* __restrict__ xin, const float* __restrict__ gain, const float* __restrict__ sc, const float* __restrict__ sh, bf16* H) {
    const int gw = blockIdx.x * NWAVES + F.wave, NGW = F.G * NWAVES;
    for (int rb = gw; rb < T / 8; rb += NGW) {
        const int r0 = rb * 8, b = r0 / SEQ;
        f32x4 ga[8], be[8];
#pragma unroll
        for (int j = 0; j < 8; ++j) { const int col = 4 * F.lane + 256 * j; const f32x4 g = *(const f32x4*)(gain + col), s = *(const f32x4*)(sc + (size_t)b * 12288 + col);
            ga[j] = g * (s + 1.0f); be[j] = *(const f32x4*)(sh + (size_t)b * 12288 + col); }
        for (int r = r0; r < r0 + 8; ++r) {
            const f32x4* xr = (const f32x4*)(xin + (size_t)r * D) + F.lane;
            f32x4 v[8]; float s = 0.f;
#pragma unroll
            for (int j = 0; j < 8; ++j) { v[j] = xr[64 * j]; s += (v[j].x * v[j].x + v[j].y * v[j].y) + (v[j].z * v[j].z + v[j].w * v[j].w); }
            const float rstd = 1.0f / sqrtf(wave_sum(s) * (1.f / D) + EPS);
            v2u* o = (v2u*)(H + (size_t)r * D) + F.lane;
#pragma unroll
            for (int j = 0; j < 8; ++j) { const f32x4 y = v[j] * rstd * ga[j] + be[j]; v2u w; w.x = cvt_pk_bf16(y.x, y.y); w.y = cvt_pk_bf16(y.z, y.w); o[64 * j] = w; }
        }
    }
}
__device__ __forceinline__ void combine_phase(Frame& F, int l, const float* __restrict__ X1, const float* __restrict__ g2, const bf16* __restrict__ YS, const int* __restrict__ tokpos,
                                              float* X2, const float* __restrict__ gain, const float* __restrict__ sc, const float* __restrict__ sh, bf16* H, float* out) {
    const int gw = blockIdx.x * NWAVES + F.wave, NGW = F.G * NWAVES;
    for (int rb = gw; rb < T / 8; rb += NGW) {
        const int r0 = rb * 8, b = r0 / SEQ;
        for (int r = r0; r < r0 + 8; ++r) {
            const int p0 = tokpos[2 * r], p1 = tokpos[2 * r + 1];
            const f32x4* xr = (const f32x4*)(X1 + (size_t)r * D) + F.lane;
            const v2u* y0 = (const v2u*)(YS + (size_t)p0 * D) + F.lane; const v2u* y1 = (const v2u*)(YS + (size_t)p1 * D) + F.lane;
            f32x4 v[8]; float s = 0.f;
#pragma unroll
            for (int j = 0; j < 8; ++j) { const int col = 4 * F.lane + 256 * j; const f32x4 g = *(const f32x4*)(g2 + (size_t)b * 12288 + col);
                const v2u a = y0[64 * j], c = y1[64 * j];
                f32x4 ys; ys.x = bf_lo(a.x) + bf_lo(c.x); ys.y = bf_hi(a.x) + bf_hi(c.x); ys.z = bf_lo(a.y) + bf_lo(c.y); ys.w = bf_hi(a.y) + bf_hi(c.y);
                v[j] = xr[64 * j] + g * ys; s += (v[j].x * v[j].x + v[j].y * v[j].y) + (v[j].z * v[j].z + v[j].w * v[j].w); }
            const float rstd = 1.0f / sqrtf(wave_sum(s) * (1.f / D) + EPS);
            if (l == 0) {
                f32x4* xo = (f32x4*)(X2 + (size_t)r * D) + F.lane; v2u* o = (v2u*)(H + (size_t)r * D) + F.lane;
#pragma unroll
                for (int j = 0; j < 8; ++j) { const int col = 4 * F.lane + 256 * j; xo[64 * j] = v[j];
                    const f32x4 g = *(const f32x4*)(gain + col), s1 = *(const f32x4*)(sc + (size_t)b * 12288 + col), h1 = *(const f32x4*)(sh + (size_t)b * 12288 + col);
                    const f32x4 y = v[j] * rstd * g * (s1 + 1.0f) + h1; v2u w; w.x = cvt_pk_bf16(y.x, y.y); w.y = cvt_pk_bf16(y.z, y.w); o[64 * j] = w; }
            } else {
                f32x4* oo = (f32x4*)(out + (size_t)r * D) + F.lane;
#pragma unroll
                for (int j = 0; j < 8; ++j) { const int col = 4 * F.lane + 256 * j; const f32x4 g = *(const f32x4*)(gain + col); oo[64 * j] = v[j] * rstd * g; }
            }
        }
    }
}

struct EpiZ {
    static constexpr bool PERM = true;
    float* ZF; bf16* ZB;
    __device__ __forceinline__ void operator()(const f32x4 (&acc)[2][2][4][2], const pg8::Unit& u, int wr, int wc, int fr, int fq) const {
        const int row0 = u.pm * 256 + wr * 64 + fr, cl = wc * 32 + 8 * fq;
        if (u.pn <= 2 || u.pn == 15) {
            const int cb = (u.pn == 15 ? 768 : u.pn * 256) + cl;
#pragma unroll
            for (int ai = 0; ai < 2; ++ai)
#pragma unroll
                for (int m = 0; m < 4; ++m) { float* rp = ZF + (size_t)(row0 + ai * 128 + m * 16) * 1024 + cb;
#pragma unroll
                    for (int bj = 0; bj < 2; ++bj) { *(f32x4*)(rp + bj * 128) = acc[ai][bj][m][0]; *(f32x4*)(rp + bj * 128 + 4) = acc[ai][bj][m][1]; } }
        } else {
            const int cb = (u.pn - 3) * 256 + cl;
#pragma unroll
            for (int ai = 0; ai < 2; ++ai)
#pragma unroll
                for (int m = 0; m < 4; ++m) { bf16* rp = ZB + (size_t)(row0 + ai * 128 + m * 16) * 3072 + cb;
#pragma unroll
                    for (int bj = 0; bj < 2; ++bj) { const f32x4 v0 = acc[ai][bj][m][0], v1 = acc[ai][bj][m][1]; v4u w;
                        w.x = cvt_pk_bf16(v0[0], v0[1]); w.y = cvt_pk_bf16(v0[2], v0[3]); w.z = cvt_pk_bf16(v1[0], v1[1]); w.w = cvt_pk_bf16(v1[2], v1[3]); *(v4u*)(rp + bj * 128) = w; } }
        }
    }
};
struct EpiQ {
    static constexpr bool PERM = true;
    bf16* QLAT; bf16* QIDX;
    __device__ __forceinline__ void operator()(const f32x4 (&acc)[2][2][4][2], const pg8::Unit& u, int wr, int wc, int fr, int fq) const {
        const int row0 = u.pm * 256 + wr * 64 + fr, cl = wc * 32 + 8 * fq;
        bf16* base; int ld, cb;
        if (u.pn < 8) { base = QLAT; ld = 2048; cb = u.pn * 256 + cl; } else { base = QIDX; ld = 512; cb = (u.pn - 8) * 256 + cl; }
#pragma unroll
        for (int ai = 0; ai < 2; ++ai)
#pragma unroll
            for (int m = 0; m < 4; ++m) { bf16* rp = base + (size_t)(row0 + ai * 128 + m * 16) * ld + cb;
#pragma unroll
                for (int bj = 0; bj < 2; ++bj) { const f32x4 v0 = acc[ai][bj][m][0], v1 = acc[ai][bj][m][1]; v4u w;
                    w.x = cvt_pk_bf16(v0[0], v0[1]); w.y = cvt_pk_bf16(v0[2], v0[3]); w.z = cvt_pk_bf16(v1[0], v1[1]); w.w = cvt_pk_bf16(v1[2], v1[3]); *(v4u*)(rp + bj * 128) = w; } }
    }
};
struct EpiRes {
    static constexpr bool PERM = false;
    const float* Xin; float* X1; const float* g1;
    __device__ __forceinline__ void operator()(const f32x4 (&acc)[2][2][4][2], const pg8::Unit& u, int wr, int wc, int fr, int fq) const {
        const int row0 = u.pm * 256 + wr * 64 + fr, col0 = u.pn * 256 + wc * 32 + 4 * fq; const int b = (u.pm * 256) / SEQ;
        f32x4 gv[2][2];
#pragma unroll
        for (int bj = 0; bj < 2; ++bj)
#pragma unroll
            for (int n = 0; n < 2; ++n) gv[bj][n] = *(const f32x4*)(g1 + (size_t)b * 12288 + col0 + bj * 128 + n * 16);
#pragma unroll
        for (int ai = 0; ai < 2; ++ai)
#pragma unroll
            for (int m = 0; m < 4; ++m) { const size_t off = (size_t)(row0 + ai * 128 + m * 16) * D + col0;
#pragma unroll
                for (int bj = 0; bj < 2; ++bj)
#pragma unroll
                    for (int n = 0; n < 2; ++n) { const f32x4 xi = *(const f32x4*)(Xin + off + bj * 128 + n * 16); *(f32x4*)(X1 + off + bj * 128 + n * 16) = xi + gv[bj][n] * acc[ai][bj][m][n]; } }
    }
};
template <int NPN> struct MoeOrder {
    static constexpr int npn = NPN;
    const int* tile_e; int ntiles, G, c;
    __device__ __forceinline__ bool next(int i, pg8::Unit& u) const { const int L = i * G + c; if (L >= ntiles * npn) return false; const int tile = L / npn, pn = L % npn; u.pm = tile; u.pn = tile_e[tile] * npn + pn; return true; }
    __device__ __forceinline__ void a_ready(const pg8::Unit&) const {}
    __device__ __forceinline__ void done(const pg8::Unit&) const {}
};
struct EpiGU {
    static constexpr bool PERM = true;
    bf16* ACT;
    __device__ __forceinline__ void operator()(const f32x4 (&acc)[2][2][4][2], const pg8::Unit& u, int wr, int wc, int fr, int fq) const {
        const int row0 = u.pm * 256 + wr * 64 + fr, cb = (u.pn & 3) * 128 + wc * 32 + 8 * fq;
#pragma unroll
        for (int ai = 0; ai < 2; ++ai)
#pragma unroll
            for (int m = 0; m < 4; ++m) { float o[8];
#pragma unroll
                for (int n = 0; n < 2; ++n)
#pragma unroll
                    for (int e = 0; e < 4; ++e) { const float g = acc[ai][0][m][n][e], up = acc[ai][1][m][n][e]; o[n * 4 + e] = g / (1.f + __expf(-g)) * up; }
                v4u w; w.x = cvt_pk_bf16(o[0], o[1]); w.y = cvt_pk_bf16(o[2], o[3]); w.z = cvt_pk_bf16(o[4], o[5]); w.w = cvt_pk_bf16(o[6], o[7]);
                *(v4u*)(ACT + (size_t)(row0 + ai * 128 + m * 16) * 512 + cb) = w; }
    }
};
struct EpiDN {
    static constexpr bool PERM = true;
    bf16* YS; const float* rowgate;
    __device__ __forceinline__ void operator()(const f32x4 (&acc)[2][2][4][2], const pg8::Unit& u, int wr, int wc, int fr, int fq) const {
        const int row0 = u.pm * 256 + wr * 64 + fr, cb = (u.pn & 7) * 256 + wc * 32 + 8 * fq;
#pragma unroll
        for (int ai = 0; ai < 2; ++ai)
#pragma unroll
            for (int m = 0; m < 4; ++m) { const int r = row0 + ai * 128 + m * 16; const float gt = rowgate[r]; bf16* rp = YS + (size_t)r * D + cb;
#pragma unroll
                for (int bj = 0; bj < 2; ++bj) { const f32x4 v0 = acc[ai][bj][m][0] * gt, v1 = acc[ai][bj][m][1] * gt; v4u w;
                    w.x = cvt_pk_bf16(v0[0], v0[1]); w.y = cvt_pk_bf16(v0[2], v0[3]); w.z = cvt_pk_bf16(v1[0], v1[1]); w.w = cvt_pk_bf16(v1[2], v1[3]); *(v4u*)(rp + bj * 128) = w; } }
    }
};

__device__ __forceinline__ float wave_scan_add(float v, int lane) {
#pragma unroll
    for (int o = 1; o < 64; o <<= 1) { const float t = __shfl_up(v, o); if (lane >= o) v += t; }
    return v;
}
__device__ __forceinline__ float wave_scan_max(float v, int lane) {
#pragma unroll
    for (int o = 1; o < 64; o <<= 1) { const float t = __shfl_up(v, o); if (lane >= o) v = fmaxf(v, t); }
    return v;
}
__device__ __forceinline__ void p3_phase(Frame& F, const float* __restrict__ ZF, const float* __restrict__ gq, const float* __restrict__ gkv, const float* __restrict__ ib, const float* __restrict__ fb,
                                         bf16* CQN, bf16* CKVN, bf16* KIDX, float* GA, float* GMX, float* GB, float* MINS) {
    const int gw = blockIdx.x * NWAVES + F.wave, NGW = F.G * NWAVES;
    for (int chain = gw; chain < 16 * NWAVES; chain += NGW) {
        if ((chain & 7) != 0) continue;
        const int ch = chain >> 3, b = ch >> 2, h = ch & 3; const float ibias = ib[h], fbias = fb[h];
        float m_in = 0.f;
        for (int k0 = 0; k0 < 64; k0 += 8) {
            float miv[8], mfv[8];
#pragma unroll
            for (int u = 0; u < 8; ++u) { const int t = b * SEQ + 64 * (k0 + u) + F.lane; miv[u] = ZF[(size_t)t * 1024 + 768 + 72 + h]; mfv[u] = ZF[(size_t)t * 1024 + 768 + 76 + h]; }
#pragma unroll
            for (int u = 0; u < 8; ++u) {
                const int k = k0 + u, t = b * SEQ + 64 * k + F.lane;
                const float mi = miv[u] + ibias, mf = mfv[u] + fbias;
                const float lf = fminf(mf, 0.f) - log1pf(__expf(-fabsf(mf)));
                const float bj = wave_scan_add(lf, F.lane);
                const float a = mi - bj;
                const float mx = fmaxf(m_in, wave_scan_max(a, F.lane));
                GA[t * 4 + h] = a; GMX[t * 4 + h] = mx; GB[t * 4 + h] = bj;
                if (F.lane == 0) MINS[ch * 65 + k] = m_in;
                m_in = __shfl(bj, 63) + __shfl(mx, 63);
            }
        }
        if (F.lane == 0) MINS[ch * 65 + 64] = m_in;
    }
    for (int rb = gw; rb < T / 8; rb += NGW) {
        const f32x4 g0 = *(const f32x4*)(gq + 4 * F.lane), g1 = *(const f32x4*)(gq + 256 + 4 * F.lane), g2 = *(const f32x4*)(gkv + 4 * F.lane);
        for (int r = rb * 8; r < rb * 8 + 8; ++r) {
            const float* zr = ZF + (size_t)r * 1024;
            const f32x4 a0 = *(const f32x4*)(zr + 4 * F.lane), a1 = *(const f32x4*)(zr + 256 + 4 * F.lane), kv = *(const f32x4*)(zr + 512 + 4 * F.lane);
            const float ki = zr[768 + F.lane];
            float s1 = (a0.x * a0.x + a0.y * a0.y) + (a0.z * a0.z + a0.w * a0.w) + (a1.x * a1.x + a1.y * a1.y) + (a1.z * a1.z + a1.w * a1.w);
            float s2 = (kv.x * kv.x + kv.y * kv.y) + (kv.z * kv.z + kv.w * kv.w);
            const float r1 = 1.0f / sqrtf(wave_sum(s1) * (1.f / 512.f) + EPS), r2 = 1.0f / sqrtf(wave_sum(s2) * (1.f / 256.f) + EPS);
            const f32x4 y0 = a0 * r1 * g0, y1 = a1 * r1 * g1, y2 = kv * r2 * g2;
            v2u w; w.x = cvt_pk_bf16(y0.x, y0.y); w.y = cvt_pk_bf16(y0.z, y0.w); *((v2u*)(CQN + (size_t)r * 512) + F.lane) = w;
            w.x = cvt_pk_bf16(y1.x, y1.y); w.y = cvt_pk_bf16(y1.z, y1.w); *((v2u*)(CQN + (size_t)r * 512 + 256) + F.lane) = w;
            w.x = cvt_pk_bf16(y2.x, y2.y); w.y = cvt_pk_bf16(y2.z, y2.w); *((v2u*)(CKVN + (size_t)r * 256) + F.lane) = w;
            KIDX[(size_t)r * 64 + F.lane] = (bf16)(cvt_pk_bf16(ki, 0.f) & 0xffffu);
        }
    }
}

__device__ __forceinline__ void m1_scan(Frame& F, const bf16* __restrict__ ZB, const float* __restrict__ GA, const float* __restrict__ GMX, const float* __restrict__ MINS, bf16* CT, float* NS) {
    LAS bf16* kT = (LAS bf16*)(F.lds); LAS bf16* vT = (LAS bf16*)(F.lds + 2 * 128 * 72 * 2);
    const int g = F.lane >> 4, n = F.lane & 15, w = F.wave;
    for (int unit = blockIdx.x; unit < 256; unit += F.G) {
        const int chain = unit >> 4, sl = unit & 15, b = chain >> 2, h = chain & 3; const int bt0 = b * SEQ;
        const int s = F.tid >> 3, dc = F.tid & 7;
        f32x4 C = (f32x4){0.f, 0.f, 0.f, 0.f}, Nacc = (f32x4){0.f, 0.f, 0.f, 0.f};
        bf16x8 ones; for (int i = 0; i < 8; ++i) ones[i] = (short)0x3F80;
        v4u kr0, kr1, vr; float wsv;
        { const int t = bt0 + s; const bf16* kp = ZB + (size_t)t * 3072 + 512 + h * 128 + dc * 16; kr0 = *(const v4u*)kp; kr1 = *(const v4u*)(kp + 8);
          vr = (v4u){0u, 0u, 0u, 0u}; if (F.tid < 128) vr = *(const v4u*)(ZB + (size_t)(bt0 + (F.tid >> 1)) * 3072 + 1024 + h * 256 + sl * 16 + (F.tid & 1) * 8);
          wsv = __expf(GA[t * 4 + h] - GMX[(bt0 + 63) * 4 + h]); }
        __syncthreads();
        for (int k = 0; k < 64; ++k) {
            const int buf = k & 1; LAS bf16* kTb = kT + buf * 128 * 72; LAS bf16* vTb = vT + buf * 16 * 72;
            { const unsigned kk[8] = {kr0.x, kr0.y, kr0.z, kr0.w, kr1.x, kr1.y, kr1.z, kr1.w};
#pragma unroll
              for (int i = 0; i < 8; ++i) { const unsigned u = cvt_pk_bf16(bf_lo(kk[i]) * wsv, bf_hi(kk[i]) * wsv);
                  kTb[(dc * 16 + 2 * i) * 72 + s] = (bf16)(u & 0xffffu); kTb[(dc * 16 + 2 * i + 1) * 72 + s] = (bf16)(u >> 16); }
              if (F.tid < 128) { const unsigned vv[4] = {vr.x, vr.y, vr.z, vr.w}; const int vs = F.tid >> 1, e8 = (F.tid & 1) * 8;
#pragma unroll
                  for (int i = 0; i < 4; ++i) { vTb[(e8 + 2 * i) * 72 + vs] = (bf16)(vv[i] & 0xffffu); vTb[(e8 + 2 * i + 1) * 72 + vs] = (bf16)(vv[i] >> 16); } } }
            const float w_old = __expf(MINS[chain * 65 + k] - GMX[(bt0 + 64 * k + 63) * 4 + h]);
            if (k + 1 < 64) { const int t = bt0 + 64 * (k + 1) + s; const bf16* kp = ZB + (size_t)t * 3072 + 512 + h * 128 + dc * 16; kr0 = *(const v4u*)kp; kr1 = *(const v4u*)(kp + 8);
                if (F.tid < 128) vr = *(const v4u*)(ZB + (size_t)(bt0 + 64 * (k + 1) + (F.tid >> 1)) * 3072 + 1024 + h * 256 + sl * 16 + (F.tid & 1) * 8);
                wsv = __expf(GA[t * 4 + h] - GMX[(bt0 + 64 * (k + 1) + 63) * 4 + h]); }
            __syncthreads();
            { bf16* cp = CT + ((size_t)(chain * 64 + k) * 256 + sl * 16 + 4 * g) * 128 + 16 * w + n;
#pragma unroll
              for (int i = 0; i < 4; ++i) cp[(size_t)i * 128] = (bf16)(cvt_pk_bf16(C[i], 0.f) & 0xffffu);
              if (sl == 0 && g == 0) NS[(size_t)(chain * 64 + k) * 128 + 16 * w + n] = Nacc[0]; }
            C = C * w_old; Nacc = Nacc * w_old;
#pragma unroll
            for (int ks = 0; ks < 2; ++ks) {
                const bf16x8 Af = *(const LAS bf16x8*)(vTb + n * 72 + 32 * ks + 8 * g);
                const bf16x8 Bf = *(const LAS bf16x8*)(kTb + (16 * w + n) * 72 + 32 * ks + 8 * g);
                C = __builtin_amdgcn_mfma_f32_16x16x32_bf16(Af, Bf, C, 0, 0, 0);
                Nacc = __builtin_amdgcn_mfma_f32_16x16x32_bf16(ones, Bf, Nacc, 0, 0, 0);
            }
        }
        __syncthreads();
    }
}

__device__ __forceinline__ void m3_out(Frame& F, const bf16* __restrict__ ZB, const float* __restrict__ GA, const float* __restrict__ GMX, const float* __restrict__ GB, const float* __restrict__ MINS,
                                       const bf16* __restrict__ CT, const float* __restrict__ NS, const float* __restrict__ gn, bf16* AO) {
    LAS bf16* vT = (LAS bf16*)(F.lds); LAS bf16* scT = (LAS bf16*)(F.lds + 36864);
    LAS float* den = (LAS float*)(F.lds + 46080); LAS float* qn = den + 64; LAS float* nin = den + 192;
    LAS float* denp = (LAS float*)(F.lds + 47616);
    LAS float* ssp = denp + 256;
    const int g = F.lane >> 4, n = F.lane & 15, w = F.wave;
    const float qs = 0.08838834764831845f;
    for (int unit = blockIdx.x; unit < 1024; unit += F.G) {
        const int chain = unit >> 6, k = unit & 63, b = chain >> 2, h = chain & 3; const int t0 = b * SEQ + 64 * k;
        __syncthreads();
        { const int s = F.tid >> 3, ec = F.tid & 7; const bf16* vp = ZB + (size_t)(t0 + s) * 3072 + 1024 + h * 256 + ec * 32;
#pragma unroll
          for (int q = 0; q < 4; ++q) { const v4u v = *(const v4u*)(vp + 8 * q); const unsigned vv[4] = {v.x, v.y, v.z, v.w};
#pragma unroll
              for (int i = 0; i < 4; ++i) { vT[(ec * 32 + 8 * q + 2 * i) * 72 + s] = (bf16)(vv[i] & 0xffffu); vT[(ec * 32 + 8 * q + 2 * i + 1) * 72 + s] = (bf16)(vv[i] >> 16); } }
          if (F.tid < 128) nin[F.tid] = NS[(size_t)(chain * 64 + k) * 128 + F.tid];
          }
        __syncthreads();
        const float m_in = MINS[chain * 65 + k];
#pragma unroll
        for (int ti = 0; ti < 2; ++ti) {
            const int id = 2 * w + ti, st = id >> 2, jt = id & 3;
            f32x4 acc = (f32x4){0.f, 0.f, 0.f, 0.f};
            if (st <= jt) {
#pragma unroll
                for (int ks = 0; ks < 4; ++ks) {
                    const bf16x8 Af = *(const bf16x8*)(ZB + (size_t)(t0 + 16 * st + n) * 3072 + 512 + h * 128 + 32 * ks + 8 * g);
                    const bf16x8 Bf = *(const bf16x8*)(ZB + (size_t)(t0 + 16 * jt + n) * 3072 + h * 128 + 32 * ks + 8 * g);
                    acc = __builtin_amdgcn_mfma_f32_16x16x32_bf16(Af, Bf, acc, 0, 0, 0);
                }
            }
            const int j = 16 * jt + n; const float mxj = GMX[(t0 + j) * 4 + h];
            float v[4], rs = 0.f;
#pragma unroll
            for (int i = 0; i < 4; ++i) { const int s = 16 * st + 4 * g + i; const float a = GA[(t0 + s) * 4 + h]; v[i] = (s <= j) ? acc[i] * qs * __expf(a - mxj) : 0.f; rs += v[i]; }
            rs += __shfl_xor(rs, 16); rs += __shfl_xor(rs, 32);
            if (g == 0) denp[st * 64 + j] = rs;
            v2u pk; pk.x = cvt_pk_bf16(v[0], v[1]); pk.y = cvt_pk_bf16(v[2], v[3]);
            *(LAS v2u*)(scT + j * 72 + 16 * st + 4 * g) = pk;
        }
        { const int j = F.tid >> 3, dc = F.tid & 7; const bf16* qp = ZB + (size_t)(t0 + j) * 3072 + h * 128 + dc * 16; const v4u q0 = *(const v4u*)qp, q1 = *(const v4u*)(qp + 8);
          const unsigned qq[8] = {q0.x, q0.y, q0.z, q0.w, q1.x, q1.y, q1.z, q1.w}; float p = 0.f;
#pragma unroll
          for (int i = 0; i < 8; ++i) p += bf_lo(qq[i]) * nin[dc * 16 + 2 * i] + bf_hi(qq[i]) * nin[dc * 16 + 2 * i + 1];
          p += __shfl_xor(p, 1); p += __shfl_xor(p, 2); p += __shfl_xor(p, 4);
          if (dc == 0) qn[j] = p * qs; }
        __syncthreads();
        f32x4 acc[2][4];
#pragma unroll
        for (int mt = 0; mt < 2; ++mt)
#pragma unroll
            for (int jt = 0; jt < 4; ++jt) acc[mt][jt] = (f32x4){0.f, 0.f, 0.f, 0.f};
#pragma unroll
        for (int ks = 0; ks < 4; ++ks) {
            bf16x8 Af[2], Bf[4];
#pragma unroll
            for (int mt = 0; mt < 2; ++mt) Af[mt] = *(const bf16x8*)(CT + ((size_t)(chain * 64 + k) * 256 + 32 * w + 16 * mt + n) * 128 + 32 * ks + 8 * g);
#pragma unroll
            for (int jt = 0; jt < 4; ++jt) Bf[jt] = *(const bf16x8*)(ZB + (size_t)(t0 + 16 * jt + n) * 3072 + h * 128 + 32 * ks + 8 * g);
#pragma unroll
            for (int mt = 0; mt < 2; ++mt)
#pragma unroll
                for (int jt = 0; jt < 4; ++jt) acc[mt][jt] = __builtin_amdgcn_mfma_f32_16x16x32_bf16(Af[mt], Bf[jt], acc[mt][jt], 0, 0, 0);
        }
        float winter[4], dn[4];
#pragma unroll
        for (int jt = 0; jt < 4; ++jt) { const int j = 16 * jt + n; const float mxj = GMX[(t0 + j) * 4 + h], bj = GB[(t0 + j) * 4 + h];
            winter[jt] = __expf(m_in - mxj); const float dd = winter[jt] * qn[j] + (((denp[j] + denp[64 + j]) + denp[128 + j]) + denp[192 + j]); dn[jt] = fmaxf(fabsf(dd), __expf(-(bj + mxj)));
#pragma unroll
            for (int mt = 0; mt < 2; ++mt) acc[mt][jt] = acc[mt][jt] * (winter[jt] * qs); }
#pragma unroll
        for (int ks = 0; ks < 2; ++ks) {
            bf16x8 Af[2], Bf[4];
#pragma unroll
            for (int mt = 0; mt < 2; ++mt) Af[mt] = *(const LAS bf16x8*)(vT + (32 * w + 16 * mt + n) * 72 + 32 * ks + 8 * g);
#pragma unroll
            for (int jt = 0; jt < 4; ++jt) Bf[jt] = *(const LAS bf16x8*)(scT + (16 * jt + n) * 72 + 32 * ks + 8 * g);
#pragma unroll
            for (int mt = 0; mt < 2; ++mt)
#pragma unroll
                for (int jt = 0; jt < 4; ++jt) acc[mt][jt] = __builtin_amdgcn_mfma_f32_16x16x32_bf16(Af[mt], Bf[jt], acc[mt][jt], 0, 0, 0);
        }
#pragma unroll
        for (int jt = 0; jt < 4; ++jt) { const float inv = 1.0f / dn[jt]; float q = 0.f;
#pragma unroll
            for (int mt = 0; mt < 2; ++mt) { acc[mt][jt] = acc[mt][jt] * inv; const f32x4 a = acc[mt][jt]; q += (a.x * a.x + a.y * a.y) + (a.z * a.z + a.w * a.w); }
            q += __shfl_xor(q, 16); q += __shfl_xor(q, 32);
            if (g == 0) ssp[w * 64 + 16 * jt + n] = q; }
        __syncthreads();
#pragma unroll
        for (int jt = 0; jt < 4; ++jt) { const int j = 16 * jt + n; float sq = 0.f;
#pragma unroll
            for (int w8 = 0; w8 < 8; ++w8) sq += ssp[w8 * 64 + j];
            const float rstd = 1.0f / sqrtf(sq * (1.f / 256.f) + EPS);
#pragma unroll
            for (int mt = 0; mt < 2; ++mt) { const int e = 32 * w + 16 * mt + 4 * g; const f32x4 gv = *(const f32x4*)(gn + h * 256 + e);
                const v2u mo = *(const v2u*)(ZB + (size_t)(t0 + j) * 3072 + 2048 + h * 256 + e);
                const float o0 = bf_lo(mo.x), o1 = bf_hi(mo.x), o2 = bf_lo(mo.y), o3 = bf_hi(mo.y);
                const f32x4 a = acc[mt][jt] * rstd * gv;
                v2u pk; pk.x = cvt_pk_bf16(a.x / (1.f + __expf(-o0)), a.y / (1.f + __expf(-o1))); pk.y = cvt_pk_bf16(a.z / (1.f + __expf(-o2)), a.w / (1.f + __expf(-o3)));
                *(v2u*)(AO + (size_t)(t0 + j) * 3072 + 2048 + h * 256 + e) = pk; } }
    }
    __syncthreads();
}

__device__ __forceinline__ unsigned off_b(unsigned row, unsigned ch) { return 256u * row + 16u * (ch ^ (((row & 3u) << 2) | ((row >> 2) & 3u))); }
__device__ __forceinline__ v2u tr_read2(unsigned a0, unsigned a1, v2u& r1) { v2u r0; asm volatile("ds_read_b64_tr_b16 %0, %2\n\tds_read_b64_tr_b16 %1, %3\n\ts_waitcnt lgkmcnt(0)" : "=&v"(r0), "=&v"(r1) : "v"(a0), "v"(a1) : "memory"); return r0; }

#ifndef MOE_ALIGN
#define MOE_ALIGN true
#endif
#ifndef MOE_SP2
#define MOE_SP2 true
#endif
#ifndef GATH_B
#define GATH_B 4
#endif
__device__ __forceinline__ void dsa_phase(Frame& F, const bf16* __restrict__ QIDX, const bf16* __restrict__ KIDX, const float* __restrict__ ZF, const bf16* __restrict__ QLAT, const bf16* __restrict__ CKVN, bf16* AO) {
    const int lane = F.lane, w = F.wave;
    LAS float* SC = (LAS float*)(F.lds);
    LAS unsigned char* kvimg = F.lds + w * 16384;
    LAS int* list = (LAS int*)(F.lds + 131072 + w * 1024);
    const unsigned kvbase = (unsigned)(size_t)kvimg;
    for (int it = 0; it < 8; ++it) {
        const int vb = blockIdx.x;
        for (int blk = vb; blk < 256; blk += F.G) {
        const int b = it >> 1, gi = (it & 1) ? (511 - blk) : blk;
        const int p0 = gi * 8, t0 = b * SEQ + p0, bt0 = b * SEQ;
        __syncthreads();
#ifndef DSA_NO_SCORE
        {
            int lo_ = lane; asm volatile("" : "+v"(lo_));
            const int hf = lo_ >> 5, n32 = lo_ & 31;
            bf16x8 Aq[2][4]; float wv[2][16];
            const int m = n32, qloc = 2 * (m >> 4) + ((m >> 2) & 1), hd = 4 * ((m >> 3) & 1) + (m & 3);
#pragma unroll
            for (int a = 0; a < 2; ++a)
#pragma unroll
                for (int ks = 0; ks < 4; ++ks) Aq[a][ks] = *(const bf16x8*)(QIDX + (size_t)(t0 + 4 * a + qloc) * 512 + hd * 64 + ks * 16 + hf * 8);
#pragma unroll
            for (int a = 0; a < 2; ++a)
#pragma unroll
                for (int i = 0; i < 16; ++i) wv[a][i] = ZF[(size_t)(t0 + 4 * a + 2 * (i >> 3) + hf) * 1024 + 768 + 64 + (i & 7)];
            const int nkt = (p0 + 7) / 32 + 1;
            for (int kt = w; kt < nkt; kt += NWAVES) {
                bf16x8 Bk[4];
#pragma unroll
                for (int ks = 0; ks < 4; ++ks) Bk[ks] = *(const bf16x8*)(KIDX + (size_t)(bt0 + 32 * kt + n32) * 64 + ks * 16 + hf * 8);
#pragma unroll
                for (int a = 0; a < 2; ++a) {
                    f32x16 acc; for (int i = 0; i < 16; ++i) acc[i] = 0.f;
#pragma unroll
                    for (int ks = 0; ks < 4; ++ks) acc = __builtin_amdgcn_mfma_f32_32x32x16_bf16(Aq[a][ks], Bk[ks], acc, 0, 0, 0);
                    float s0 = 0.f, s1 = 0.f;
#pragma unroll
                    for (int i = 0; i < 8; ++i) { s0 += wv[a][i] * fmaxf(acc[i], 0.f); s1 += wv[a][8 + i] * fmaxf(acc[8 + i], 0.f); }
                    SC[(4 * a + hf) * 4096 + 32 * kt + n32] = s0; SC[(4 * a + 2 + hf) * 4096 + 32 * kt + n32] = s1;
                }
            }
        }
#endif
        __syncthreads();
        const int p = p0 + w, t = t0 + w; int count;
        if (p < 256) { count = p + 1;
#pragma unroll
            for (int i = 0; i < 4; ++i) { const int idx = 64 * i + lane; list[idx] = idx <= p ? idx : 0; }
        } else {
            count = 256;
#ifndef DSA_NO_SEL
            unsigned key[64];
            const LAS float* srow = SC + w * 4096;
#pragma unroll
            for (int i = 0; i < 64; ++i) { const int s = 64 * i + lane; unsigned u = 0u;
                if (64 * i <= p) { const unsigned bits = __builtin_bit_cast(unsigned, srow[s]); u = (bits & 0x80000000u) ? ~bits : (bits | 0x80000000u); if (s > p) u = 0u; }
                key[i] = u; }
            unsigned Tm = 0u; int cge = 0; bool exact = false;
            for (int bit = 31; bit >= 0; --bit) {
                const unsigned cand = Tm | (1u << bit); int c = 0;
#pragma unroll
                for (int i = 0; i < 64; ++i) c += __popcll(__ballot(key[i] >= cand));
                if (c >= 256) { Tm = cand; cge = c; if (c == 256) { exact = true; break; } }
            }
            (void)cge; (void)exact;
            int base = 0;
#pragma unroll
            for (int i = 0; i < 64; ++i) { const bool pr = key[i] > Tm; const unsigned long long mk = __ballot(pr); const int pos = base + __builtin_amdgcn_mbcnt_hi((unsigned)(mk >> 32), __builtin_amdgcn_mbcnt_lo((unsigned)mk, 0u));
                if (pr) list[pos] = 64 * i + lane; base += __popcll(mk); }
#pragma unroll
            for (int i = 0; i < 64; ++i) { const bool pr = key[i] == Tm; const unsigned long long mk = __ballot(pr); const int pos = base + __builtin_amdgcn_mbcnt_hi((unsigned)(mk >> 32), __builtin_amdgcn_mbcnt_lo((unsigned)mk, 0u));
                if (pr && pos < 256) list[pos] = 64 * i + lane; base += __popcll(mk); }
#endif
        }
        LDS_WAIT(); asm volatile("" ::: "memory");
#ifndef DSA_NO_ATT
        {
            int lo_ = lane; asm volatile("" : "+v"(lo_));
            const int hf = lo_ >> 5, n32 = lo_ & 31, g = lo_ >> 4, n = lo_ & 15;
            bf16x8 qb[8];
#pragma unroll
            for (int s = 0; s < 8; ++s) { if (n < 8) qb[s] = *(const bf16x8*)(QLAT + (size_t)t * 2048 + n * 256 + 32 * s + 8 * g); else { for (int i = 0; i < 8; ++i) qb[s][i] = 0; } }
            f32x4 O[16];
#pragma unroll
            for (int c = 0; c < 16; ++c) O[c] = (f32x4){0.f, 0.f, 0.f, 0.f};
            float m_run = -1e30f, l_run = 0.f;
            const int nch = (count + 31) >> 5;
            const unsigned rowA0 = 8u * (unsigned)(n >> 2) + (unsigned)(n & 3);
            for (int ch = 0; ch < nch; ++ch) {
                {
                    const int rsub = g, cpos = n;
#pragma unroll
                    for (int rgp = 0; rgp < 8; ++rgp) {
                        const int row = 4 * rgp + rsub; const int idx = list[32 * ch + row];
                        const int chn = cpos ^ ((rsub << 2) | (rgp & 3));
                        const bf16* src = CKVN + (size_t)(bt0 + idx) * 256 + chn * 8;
                        __builtin_amdgcn_global_load_lds((const unsigned*)src, (LAS unsigned*)(kvimg + rgp * 1024), 16, 0, 0);
                        __builtin_amdgcn_global_load_lds((const unsigned*)(src + 128), (LAS unsigned*)(kvimg + 8192 + rgp * 1024), 16, 0, 0);
                    }
                }
                asm volatile("s_waitcnt vmcnt(0)" ::: "memory");
                f32x4 st[2];
#pragma unroll
                for (int rb = 0; rb < 2; ++rb) { st[rb] = (f32x4){0.f, 0.f, 0.f, 0.f};
#pragma unroll
                    for (int s = 0; s < 8; ++s) { const bf16x8 a = *(const LAS bf16x8*)(kvimg + (s >> 2) * 8192 + off_b(rowA0 + 4u * rb, 4u * (s & 3) + g));
                        st[rb] = __builtin_amdgcn_mfma_f32_16x16x32_bf16(a, qb[s], st[rb], 0, 0, 0); } }
                float pv[8]; float mx = -1e30f;
#pragma unroll
                for (int rb = 0; rb < 2; ++rb)
#pragma unroll
                    for (int i = 0; i < 4; ++i) { const int kp = 32 * ch + 8 * g + 4 * rb + i; const float sv = (kp < count) ? st[rb][i] : -1e30f; pv[rb * 4 + i] = sv; mx = fmaxf(mx, sv); }
                mx = fmaxf(mx, __shfl_xor(mx, 16)); mx = fmaxf(mx, __shfl_xor(mx, 32));
                const float m_new = fmaxf(m_run, mx), alpha = exp2f(m_run - m_new); m_run = m_new;
                float ps = 0.f;
#pragma unroll
                for (int i = 0; i < 8; ++i) { pv[i] = exp2f(pv[i] - m_new); ps += pv[i]; }
                l_run = l_run * alpha + ps;
#pragma unroll
                for (int c = 0; c < 16; ++c) O[c] = O[c] * alpha;
                bf16x8 pb; { v4u pk; pk.x = cvt_pk_bf16(pv[0], pv[1]); pk.y = cvt_pk_bf16(pv[2], pv[3]); pk.z = cvt_pk_bf16(pv[4], pv[5]); pk.w = cvt_pk_bf16(pv[6], pv[7]); pb = __builtin_bit_cast(bf16x8, pk); }
                const unsigned q4 = (unsigned)(n >> 2), p4 = (unsigned)(n & 3);
#pragma unroll
                for (int c = 0; c < 16; ++c) {
                    const unsigned ib = kvbase + (unsigned)(c >> 3) * 8192u, cc = (unsigned)(c & 7);
                    const unsigned a0 = ib + off_b(8u * g + q4, 2u * cc + (p4 >> 1)) + 8u * (p4 & 1u), a1 = ib + off_b(8u * g + 4u + q4, 2u * cc + (p4 >> 1)) + 8u * (p4 & 1u);
                    v2u r1; const v2u r0 = tr_read2(a0, a1, r1);
                    v4u av; av.x = r0.x; av.y = r0.y; av.z = r1.x; av.w = r1.y;
                    O[c] = __builtin_amdgcn_mfma_f32_16x16x32_bf16(__builtin_bit_cast(bf16x8, av), pb, O[c], 0, 0, 0);
                }
            }
            float lt = l_run; lt += __shfl_xor(lt, 16); lt += __shfl_xor(lt, 32);
            const float inv = 1.0f / lt;
            if (n < 8) {
#pragma unroll
                for (int c = 0; c < 16; ++c) { const f32x4 o = O[c] * inv; v2u pk; pk.x = cvt_pk_bf16(o.x, o.y); pk.y = cvt_pk_bf16(o.z, o.w);
                    *(v2u*)(AO + (size_t)t * 3072 + n * 256 + 16 * c + 4 * g) = pk; }
            }
        }
#endif
        }
    }
    __syncthreads();
}

__device__ __forceinline__ void router_phase(Frame& F, const bf16* __restrict__ H, const bf16* __restrict__ WR, const float* __restrict__ rbias, int* ecnt, int* EIDX, float* GATE, int* RANK) {
    LAS float* lg = (LAS float*)(F.lds) + F.wave * (16 * 33);
    LAS int* hist = (LAS int*)(F.lds + 32768); LAS int* basee = hist + 32;
    const int g = F.lane >> 4, n = F.lane & 15;
    for (int tb = blockIdx.x; tb < 256; tb += F.G) {
        __syncthreads();
        if (F.tid < 32) hist[F.tid] = 0;
        __syncthreads();
        int e0 = 0, e1 = 0, lr0 = 0, lr1 = 0; float g0 = 0.f, g1 = 0.f; const int r0 = tb * 64 + F.wave * 16;
        if (F.wave < 4) {
            f32x4 acc[2] = {(f32x4){0.f, 0.f, 0.f, 0.f}, (f32x4){0.f, 0.f, 0.f, 0.f}};
            for (int s = 0; s < 64; ++s) {
                const bf16x8 Af = *(const bf16x8*)(H + (size_t)(r0 + n) * D + 32 * s + 8 * g);
#pragma unroll
                for (int nt = 0; nt < 2; ++nt) { const bf16x8 Bf = *(const bf16x8*)(WR + (size_t)(16 * nt + n) * D + 32 * s + 8 * g); acc[nt] = __builtin_amdgcn_mfma_f32_16x16x32_bf16(Af, Bf, acc[nt], 0, 0, 0); }
            }
#pragma unroll
            for (int nt = 0; nt < 2; ++nt)
#pragma unroll
                for (int i = 0; i < 4; ++i) lg[(4 * g + i) * 33 + 16 * nt + n] = acc[nt][i];
            LDS_WAIT(); asm volatile("" ::: "memory");
            if (F.lane < 16) {
                const LAS float* row = lg + F.lane * 33;
                float best = -1e30f; int bg = 0;
                for (int gi = 0; gi < 4; ++gi) { float m1 = -1e30f, m2 = -1e30f;
                    for (int j = 0; j < 8; ++j) { const int e = gi * 8 + j; const float sel = 1.f / (1.f + __expf(-row[e])) + rbias[e]; if (sel > m1) { m2 = m1; m1 = sel; } else if (sel > m2) m2 = sel; }
                    const float gs = m1 + m2; if (gs > best) { best = gs; bg = gi; } }
                float m1 = -1e30f, m2 = -1e30f; int i1 = 0, i2 = 0;
                for (int j = 0; j < 8; ++j) { const int e = bg * 8 + j; const float sel = 1.f / (1.f + __expf(-row[e])) + rbias[e];
                    if (sel > m1) { m2 = m1; i2 = i1; m1 = sel; i1 = j; } else if (sel > m2) { m2 = sel; i2 = j; } }
                e0 = bg * 8 + i1; e1 = bg * 8 + i2;
                const float a0 = 1.f / (1.f + __expf(-row[e0])), a1 = 1.f / (1.f + __expf(-row[e1]));
                g0 = a0 / (a0 + a1); g1 = a1 / (a0 + a1);
                lr0 = __hip_atomic_fetch_add(&hist[e0], 1, __ATOMIC_RELAXED, __HIP_MEMORY_SCOPE_WORKGROUP); lr1 = __hip_atomic_fetch_add(&hist[e1], 1, __ATOMIC_RELAXED, __HIP_MEMORY_SCOPE_WORKGROUP);
            }
        }
        __syncthreads();
        if (F.tid < 32) basee[F.tid] = atomicAdd(&ecnt[F.tid], hist[F.tid]);
        __syncthreads();
        if (F.wave < 4 && F.lane < 16) { const int t = r0 + F.lane;
            EIDX[2 * t] = e0; EIDX[2 * t + 1] = e1; GATE[2 * t] = g0; GATE[2 * t + 1] = g1; RANK[2 * t] = basee[e0] + lr0; RANK[2 * t + 1] = basee[e1] + lr1; }
    }
    __syncthreads();
}
__device__ __forceinline__ void scatter_phase(Frame& F, const bf16* __restrict__ H, const int* __restrict__ ecnt, const int* __restrict__ EIDX, const float* __restrict__ GATE, const int* __restrict__ RANK,
                                              bf16* XS, int* TOKPOS, float* ROWGATE, int* TILEE, int* NT) {
    LAS int* offs = (LAS int*)(F.lds);
    __syncthreads();
    if (F.tid == 0) { int o = 0; for (int e = 0; e < NE; ++e) { offs[e] = o; o += ((ecnt[e] + 255) >> 8) << 8; } offs[NE] = o; }
    __syncthreads();
    if (blockIdx.x == 0) { if (F.tid < NE) { const int t0 = offs[F.tid] >> 8, t1 = offs[F.tid + 1] >> 8; for (int tt = t0; tt < t1; ++tt) TILEE[tt] = F.tid; } if (F.tid == 0) NT[0] = offs[NE] >> 8; }
    const int gw = blockIdx.x * NWAVES + F.wave, NGW = F.G * NWAVES;
    for (int rb = gw; rb < T / 8; rb += NGW) {
        for (int t = rb * 8; t < rb * 8 + 8; ++t) {
            const v4u* src = (const v4u*)(H + (size_t)t * D) + F.lane; v4u v[4];
#pragma unroll
            for (int j = 0; j < 4; ++j) v[j] = src[64 * j];
#pragma unroll
            for (int kk = 0; kk < 2; ++kk) { const int e = EIDX[2 * t + kk], pos = offs[e] + RANK[2 * t + kk];
                v4u* dst = (v4u*)(XS + (size_t)pos * D) + F.lane;
#pragma unroll
                for (int j = 0; j < 4; ++j) dst[64 * j] = v[j];
                if (F.lane == 0) { TOKPOS[2 * t + kk] = pos; ROWGATE[pos] = GATE[2 * t + kk]; } }
        }
    }
}

constexpr int PH_PER_LAYER = 13, N_PHASES = 1 + 2 * PH_PER_LAYER;
#ifndef PHMASK
#define PHMASK 0xFFFFF
#endif
#define EN(j) (ONLY < 0 ? (((PHMASK) >> (j)) & 1) : (((j) < 14 && ONLY == (j)) || ((j) == 14 && ONLY == 5) || ((j) == 15 && ONLY == 14)))
template <int ONLY> __global__ void __launch_bounds__(NTHR, 2) mk_fwd(Args args) {
    extern __shared__ __attribute__((aligned(16))) unsigned char lds_raw[];
    Frame F; F.lds = (LAS unsigned char*)lds_raw; F.tid = threadIdx.x; F.lane = F.tid & 63; const int wave0 = __builtin_amdgcn_readfirstlane(F.tid >> 6); F.wave = wave0; F.G = gridDim.x; F.ws = args.ws; F.ka = nullptr;
    volatile LAS unsigned* MISC = (volatile LAS unsigned*)(F.lds + MISC_OFF);
    if (F.tid < 16) MISC[F.tid] = 0u;
    __syncthreads();
    unsigned* ctl = (unsigned*)(F.ws + WS_CTL);
    const int lo = args.ph_lo, hi = args.ph_hi; const bool multi = (hi - lo) > 1;
    XcdBarrier bar; bar.bar = ctl + CW_BAR; bar.x = 0; bar.st = MISC + 8;
    if (multi) bar = xcd_barrier_post(ctl + CW_BAR, MISC + 8);
#define IN(k) (lo <= (k) && (k) < hi)
#define SEAM(k) do { if (IN(k) && IN((k) + 1)) xcd_barrier(bar); } while (0)
#define REFRESH() do { int l_; asm volatile("v_mbcnt_lo_u32_b32 %0, -1, 0\n\tv_mbcnt_hi_u32_b32 %0, -1, %0" : "=v"(l_)); F.lane = l_; F.wave = wave0; F.tid = wave0 * 64 + l_; \
    const char __attribute__((address_space(4)))* k_ = (const char __attribute__((address_space(4)))*)__builtin_amdgcn_kernarg_segment_ptr(); asm volatile("" : "+s"(k_)); F.ka = k_; F.ws = *(unsigned char* const __attribute__((address_space(4)))*)(k_ + 184); } while (0)
#define AOUT (*(float* const __attribute__((address_space(4)))*)(F.ka + 176))
#define WSB (F.ws)
#define MOD ((float*)(WSB + WS_MOD))
#define Hb ((bf16*)(WSB + WS_H))
#define ZF ((float*)(WSB + WS_ZF))
#define ZB ((bf16*)(WSB + WS_ZB))
#define CQN ((bf16*)(WSB + WS_CQN))
#define CKVN ((bf16*)(WSB + WS_CKVN))
#define KIDX ((bf16*)(WSB + WS_KIDX))
#define QLAT ((bf16*)(WSB + WS_QLAT))
#define QIDX ((bf16*)(WSB + WS_QIDX))
#define AO ((bf16*)(WSB + WS_AO))
#define X1 ((float*)(WSB + WS_X1))
#define X2 ((float*)(WSB + WS_X2))
#define GA ((float*)(WSB + WS_GATE + GATE_GA))
#define GMX ((float*)(WSB + WS_GATE + GATE_GMX))
#define GB ((float*)(WSB + WS_GATE + GATE_GB))
#define MINS ((float*)(WSB + WS_GATE + GATE_MINS))
#define CT ((bf16*)(WSB + WS_CT))
#define NS ((float*)(WSB + WS_NS))
#define XS ((bf16*)(WSB + WS_XS))
#define ACT ((bf16*)(WSB + WS_ACT))
#define YS ((bf16*)(WSB + WS_YS))
#define EIDX ((int*)(WSB + WS_RT + RT_EIDX))
#define GATE ((float*)(WSB + WS_RT + RT_GATE))
#define RANK ((int*)(WSB + WS_RT + RT_RANK))
#define TOKPOS ((int*)(WSB + WS_RT + RT_TOKPOS))
#define ROWGATE ((float*)(WSB + WS_RT + RT_ROWGATE))
#define TILEE ((int*)(WSB + WS_RT + RT_TILEE))
#define NTp ((int*)(WSB + WS_RT + RT_NT))
#define ECNT(l) ((int*)(WSB + WS_CTL) + CW_ECNT + (l) * 32)

    if (EN(13) && IN(0)) { REFRESH(); p0_prologue(F); }
    SEAM(0);
    for (int l = 0; l < 2; ++l) {
        const int pb = 1 + l * PH_PER_LAYER;
#define mod (MOD + (size_t)l * 4 * 12288)
        if (EN(0) && IN(pb + 0)) { REFRESH(); if (l == 0) norm_phase(F, AIN(0), AIN(4), mod + 2048, mod, Hb); }
        SEAM(pb + 0);
        if (EN(1) && IN(pb + 1)) { REFRESH(); pg8::Gemm gm{Hb, (const bf16*)(WSB + WS_WIN) + (size_t)l * NZ * D, T, NZ, D}; pg8::StaticOrder S; S.init(T, NZ, F.G, (int)blockIdx.x);
            EpiZ E{ZF, ZB}; pg8::gemm_phase<EpiZ, pg8::StaticOrder, true, true>(F.lds, gm, S, E, F.wave); }
        SEAM(pb + 1);
        if (EN(2) && IN(pb + 2)) { REFRESH(); p3_phase(F, ZF, AIN(6) + l * 512, AIN(7) + l * 256, AIN(12) + l * 4, AIN(13) + l * 4, CQN, CKVN, KIDX, GA, GMX, GB, MINS); }
        SEAM(pb + 2);
        if (EN(3) && IN(pb + 3)) { REFRESH(); pg8::Gemm gm{CQN, (const bf16*)(WSB + WS_WQ) + (size_t)l * 2560 * 512, T, 2560, 512}; pg8::StaticOrder S; S.init(T, 2560, F.G, (int)blockIdx.x);
            EpiQ E{QLAT, QIDX}; pg8::gemm_phase<EpiQ, pg8::StaticOrder, true, true>(F.lds, gm, S, E, F.wave); }
        SEAM(pb + 3);
        if (EN(4) && IN(pb + 4)) { REFRESH(); m1_scan(F, ZB, GA, GMX, MINS, CT, NS); }
        SEAM(pb + 4);
        if ((EN(5) || EN(15)) && IN(pb + 5)) { if (EN(14)) { REFRESH(); dsa_phase(F, QIDX, KIDX, ZF, QLAT, CKVN, AO); } if (EN(15)) { REFRESH(); m3_out(F, ZB, GA, GMX, GB, MINS, CT, NS, AIN(14) + l * 1024, AO); } }
        SEAM(pb + 5);
        if (EN(6) && IN(pb + 6)) { REFRESH(); pg8::Gemm gm{AO, (const bf16*)(WSB + WS_WOUT) + (size_t)l * 2048 * 3072, T, 2048, 3072}; pg8::StaticOrder S; S.init(T, 2048, F.G, (int)blockIdx.x);
            EpiRes E{(l == 0) ? AIN(0) : (const float*)X2, X1, mod + 2 * 2048}; pg8::gemm_phase<EpiRes, pg8::StaticOrder, true, true>(F.lds, gm, S, E, F.wave); }
        SEAM(pb + 6);
        if (EN(7) && IN(pb + 7)) { REFRESH(); norm_phase(F, X1, AIN(16) + l * 2048, mod + 4 * 2048, mod + 3 * 2048, Hb); }
        SEAM(pb + 7);
        if (EN(8) && IN(pb + 8)) { REFRESH(); router_phase(F, Hb, (const bf16*)(WSB + WS_WR), AIN(18), ECNT(l), EIDX, GATE, RANK); }
        SEAM(pb + 8);
        if (EN(9) && IN(pb + 9)) { REFRESH(); scatter_phase(F, Hb, ECNT(l), EIDX, GATE, RANK, XS, TOKPOS, ROWGATE, TILEE, NTp); }
        SEAM(pb + 9);
        if (EN(10) && IN(pb + 10)) { REFRESH(); pg8::Gemm gm{XS, (const bf16*)(WSB + WS_WGU) + (size_t)l * 32 * 1024 * 2048, MPAD, 32 * 1024, 2048}; MoeOrder<4> S{TILEE, NTp[0], F.G, (int)blockIdx.x};
            EpiGU E{ACT}; pg8::gemm_phase<EpiGU, MoeOrder<4>, MOE_ALIGN, MOE_SP2>(F.lds, gm, S, E, F.wave); }
        SEAM(pb + 10);
        if (EN(11) && IN(pb + 11)) { REFRESH(); pg8::Gemm gm{ACT, (const bf16*)(WSB + WS_WD) + (size_t)l * 32 * 2048 * 512, MPAD, 32 * 2048, 512}; MoeOrder<8> S{TILEE, NTp[0], F.G, (int)blockIdx.x};
            EpiDN E{YS, ROWGATE}; pg8::gemm_phase<EpiDN, MoeOrder<8>, MOE_ALIGN, MOE_SP2>(F.lds, gm, S, E, F.wave); }
        SEAM(pb + 11);
        if (EN(12) && IN(pb + 12)) { REFRESH(); const float* mod1 = MOD + (size_t)4 * 12288;
            if (l == 0) combine_phase(F, 0, X1, mod + 5 * 2048, YS, TOKPOS, X2, AIN(4) + 2048, mod1 + 2048, mod1, Hb, nullptr);
            else combine_phase(F, 1, X1, mod + 5 * 2048, YS, TOKPOS, nullptr, AIN(21), nullptr, nullptr, nullptr, AOUT); }
        SEAM(pb + 12);
    }
#undef IN
#undef SEAM
}

#ifndef MK_N_LAUNCHES
#define MK_N_LAUNCHES 1
#endif
extern "C" void kernel_launch(void* const* d_in, const int* in_sizes, int n_in, void* d_out, int out_size, void* d_ws, size_t ws_size, hipStream_t stream) {
    static int grid = 0;
    if (grid == 0) {
        if (n_in != 22 || out_size != T * D || ws_size < WS_END) { fprintf(stderr, "kernel_launch: unexpected problem (n_in %d out %d ws %zu)\n", n_in, out_size, ws_size); grid = -1; return; }
        int dev = 0, cus = 0, per_cu = 0;
        if (hipGetDevice(&dev) != hipSuccess || hipDeviceGetAttribute(&cus, hipDeviceAttributeMultiprocessorCount, dev) != hipSuccess) { grid = -1; return; }
        bool ok = true;
#define SETATTR(K) ok = ok && (hipFuncSetAttribute((const void*)mk_fwd<K>, hipFuncAttributeMaxDynamicSharedMemorySize, LDS_BYTES) == hipSuccess)
#if MK_N_LAUNCHES == 1
        SETATTR(-1);
#else
        SETATTR(14); SETATTR(0); SETATTR(1); SETATTR(2); SETATTR(3); SETATTR(4); SETATTR(5); SETATTR(6); SETATTR(7); SETATTR(8); SETATTR(9); SETATTR(10); SETATTR(11); SETATTR(12); SETATTR(13);
#endif
#undef SETATTR
        if (!ok) { fprintf(stderr, "kernel_launch: hipFuncSetAttribute failed\n"); grid = -1; return; }
        if (hipOccupancyMaxActiveBlocksPerMultiprocessor(&per_cu, (const void*)mk_fwd<(MK_N_LAUNCHES == 1 ? -1 : 1)>, NTHR, LDS_BYTES) != hipSuccess || per_cu < 1) fprintf(stderr, "kernel_launch: occupancy query says %d\n", per_cu);
        (void)hipGetLastError();
        grid = cus;
    }
    if (grid < 0) return;
    (void)hipMemsetAsync((char*)d_ws + WS_CTL, 0, CTL_ZERO_BYTES, stream);
    Args a{};
    for (int i = 0; i < 22; ++i) a.in[i] = (const float*)d_in[i];
    a.out = (float*)d_out; a.ws = (unsigned char*)d_ws;
#if MK_N_LAUNCHES == 1
    { a.ph_lo = 0; a.ph_hi = N_PHASES; hipLaunchKernelGGL(mk_fwd<-1>, dim3(grid), dim3(NTHR), LDS_BYTES, stream, a); }
#else
    {
        for (int p = 0; p < N_PHASES; ++p) {
            if (p == 1 + PH_PER_LAYER) continue;
            a.ph_lo = p; a.ph_hi = p + 1;
            const int j = (p == 0) ? 13 : (p - 1) % PH_PER_LAYER;
#define LCASE(K) case K: hipLaunchKernelGGL(mk_fwd<K>, dim3(grid), dim3(NTHR), LDS_BYTES, stream, a); break
            if (j == 5) hipLaunchKernelGGL(mk_fwd<14>, dim3(grid), dim3(NTHR), LDS_BYTES, stream, a);
            switch (j) { LCASE(0); LCASE(1); LCASE(2); LCASE(3); LCASE(4); LCASE(5); LCASE(6); LCASE(7); LCASE(8); LCASE(9); LCASE(10); LCASE(11); LCASE(12); LCASE(13); }
#undef LCASE
        }
    }
#endif
}
```

```cpp
#include <hip/hip_runtime.h>
#include <cstdio>
#include <cstdint>

#define LAS __attribute__((address_space(3)))
#define GAS __attribute__((address_space(1)))
typedef unsigned short bf16;
typedef short bf16x8 __attribute__((ext_vector_type(8)));
typedef float f32x4 __attribute__((ext_vector_type(4)));
typedef float f32x16 __attribute__((ext_vector_type(16)));
typedef unsigned v4u __attribute__((ext_vector_type(4)));
typedef unsigned v2u __attribute__((ext_vector_type(2)));
#define LDS_WAIT() asm volatile("s_waitcnt lgkmcnt(0)" ::: "memory")
#define VM_WAIT() asm volatile("s_waitcnt vmcnt(0)" ::: "memory")

typedef __bf16 bf16x2_t __attribute__((ext_vector_type(2)));
typedef float f32x2_t __attribute__((ext_vector_type(2)));
__device__ __forceinline__ unsigned cvt_pk_bf16(float lo, float hi) { const f32x2_t f = {lo, hi}; const bf16x2_t b = __builtin_convertvector(f, bf16x2_t); return __builtin_bit_cast(unsigned, b); }
__device__ __forceinline__ float bf_lo(unsigned u) { return __builtin_bit_cast(float, u << 16); }
__device__ __forceinline__ float bf_hi(unsigned u) { return __builtin_bit_cast(float, u & 0xffff0000u); }
__device__ __forceinline__ float wave_sum(float v) {
#pragma unroll
    for (int o = 1; o < 64; o <<= 1) v += __shfl_xor(v, o);
    return v;
}

namespace pg8 {
typedef unsigned short bf16_t;
constexpr int BM = 256, BK = 64, HALF = 128, HTB = HALF * BK * 2, STAGE_BYTES = 8 * HTB, NXCD = 8, WGM = 8;
__host__ __device__ __forceinline__ int lds_byte(int r, int c) { const int st = (r >> 4) * 2 + (c >> 5), rr = r & 15, cc = c & 31, ob = rr * 64 + cc * 2; return st * 1024 + (ob ^ (((ob >> 9) & 1) << 5)); }
__host__ __device__ __forceinline__ void stage_rc(int b, int& R, int& C) { const int st = b / 1024, sb = b % 1024, swz = sb ^ (((sb >> 9) & 1) << 5); R = (st >> 1) * 16 + swz / 64; C = (st & 1) * 32 + (swz % 64) / 2; }
__host__ __device__ __forceinline__ int perm32(int rho) { const int n = rho >> 4, i = rho & 15; return 8 * (i >> 2) + 4 * n + (i & 3); }
struct Unit { int pm, pn; };
struct Gemm { const bf16_t* A; const bf16_t* Bt; int M, N, K; };
struct StaticOrder {
    int nM, nN, nwg, G, c;
    __host__ __device__ void init(int M, int N, int G_, int c_) { nM = M / BM; nN = N / BM; nwg = nM * nN; G = G_; c = c_; }
    __host__ __device__ bool next(int i, Unit& u) const {
        const long L = (long)i * G + c; if (L >= nwg) return false;
        int wgid = (int)L; { const int q = nwg / NXCD, r = nwg % NXCD, xcd = wgid % NXCD, off = wgid / NXCD; wgid = (xcd < r ? xcd * (q + 1) : r * (q + 1) + (xcd - r) * q) + off; }
        const int nig = WGM * nN, gid = wgid / nig, fm = gid * WGM, gsz = (nM - fm) < WGM ? (nM - fm) : WGM;
        u.pm = fm + ((wgid % nig) % gsz); u.pn = (wgid % nig) / gsz; return true;
    }
    __device__ __forceinline__ void a_ready(const Unit&) const {}
    __device__ __forceinline__ void done(const Unit&) const {}
};
template <class Epi, class Sched, bool ALIGN_EPI = false, bool SP2 = false>
__device__ __forceinline__ void gemm_phase(LAS unsigned char* lds, const Gemm g, const Sched& S, const Epi& E, const int wave_id) {
    int lane; asm volatile("v_mbcnt_lo_u32_b32 %0, -1, 0\n\tv_mbcnt_hi_u32_b32 %0, -1, %0" : "=v"(lane));
    const int wid = wave_id, tid = wid * 64 + lane;
    const int wr = wid >> 2, wc = wid & 3, fr = lane & 15, fq = lane >> 4;
    const int K = g.K, nt = K / BK;
    unsigned voffA[2], voffB[2];
#pragma unroll
    for (int i = 0; i < 2; ++i) { int R, C; stage_rc(tid * 16 + i * 8192, R, C); const int Rb = Epi::PERM ? ((R & ~31) + perm32(R & 31)) : R;
        voffA[i] = (unsigned)(R * K + C) * 2u; voffB[i] = (unsigned)(Rb * K + C) * 2u; }
    const size_t kstep = (size_t)(BK * 2);
    const size_t hstep = (size_t)HALF * K * 2;
    const size_t tstep = 2 * hstep;
    const unsigned ldsw = (unsigned)wid * 1024u;
    const int aoff = lds_byte(wr * 64 + fr, fq * 8), boff = lds_byte(wc * 32 + fr, fq * 8);
#define PG8_SA(b, h) (((b) * 2 + (h)) * HTB)
#define PG8_SB(b, h) ((4 + (b) * 2 + (h)) * HTB)
#define PG8_STAGE(bufoff, gbase, voff) do { _Pragma("unroll") for (int _i = 0; _i < 2; ++_i) \
        __builtin_amdgcn_global_load_lds((const unsigned*)((const char*)(gbase) + (voff)[_i]), (LAS unsigned*)(lds + (bufoff) + ldsw + _i * 8192), 16, 0, 0); } while (0)
#define PG8_LDA(dst, b, h) do { _Pragma("unroll") for (int m = 0; m < 4; ++m) _Pragma("unroll") for (int k = 0; k < 2; ++k) dst[m][k] = *(const LAS bf16x8*)(lds + PG8_SA(b, h) + aoff + m * 2048 + k * 1024); } while (0)
#define PG8_LDB(dst, b, h) do { _Pragma("unroll") for (int n = 0; n < 2; ++n) _Pragma("unroll") for (int k = 0; k < 2; ++k) dst[n][k] = *(const LAS bf16x8*)(lds + PG8_SB(b, h) + boff + n * 2048 + k * 1024); } while (0)
#define PG8_MMA(ai, bj, At, Bt) do { __builtin_amdgcn_s_setprio(1); _Pragma("unroll") for (int m = 0; m < 4; ++m) _Pragma("unroll") for (int n = 0; n < 2; ++n) _Pragma("unroll") for (int k = 0; k < 2; ++k) \
        acc[ai][bj][m][n] = __builtin_amdgcn_mfma_f32_16x16x32_bf16(Bt[n][k], At[m][k], acc[ai][bj][m][n], 0, 0, 0); __builtin_amdgcn_s_setprio(0); } while (0)
#define PG8_WAIT_V(n) asm volatile("s_waitcnt vmcnt(" #n ")" ::: "memory")
#define PG8_WAIT_L(n) asm volatile("s_waitcnt lgkmcnt(" #n ")" ::: "memory")
#define PG8_BAR __builtin_amdgcn_s_barrier()
#define PG8_SCHED __builtin_amdgcn_sched_barrier(0)
    Unit cur, nxt; int ui = 0;
    if (!S.next(0, cur)) return;
    f32x4 acc[2][2][4][2];
#pragma unroll
    for (int a = 0; a < 2; ++a)
#pragma unroll
        for (int b = 0; b < 2; ++b)
#pragma unroll
            for (int m = 0; m < 4; ++m)
#pragma unroll
                for (int n = 0; n < 2; ++n) acc[a][b][m][n] = (f32x4){0.f, 0.f, 0.f, 0.f};
    bf16x8 At[4][2], B0[2][2], B1[2][2];
    const char* cA = (const char*)g.A + (size_t)cur.pm * tstep; const char* cB = (const char*)g.Bt + (size_t)cur.pn * tstep;
    S.a_ready(cur);
    if constexpr (SP2) {
        PG8_STAGE(PG8_SB(0, 0), cB, voffB); PG8_STAGE(PG8_SB(0, 1), cB + hstep, voffB); PG8_STAGE(PG8_SA(0, 0), cA, voffA); PG8_STAGE(PG8_SA(0, 1), cA + hstep, voffA);
        if (wr == 1) PG8_BAR;
        PG8_WAIT_V(2); PG8_BAR;
        PG8_STAGE(PG8_SB(1, 0), cB + kstep, voffB); PG8_STAGE(PG8_SA(1, 0), cA + kstep, voffA); PG8_STAGE(PG8_SB(1, 1), cB + hstep + kstep, voffB);
        PG8_WAIT_V(6); PG8_BAR;
    } else {
        PG8_STAGE(PG8_SB(0, 0), cB, voffB); PG8_STAGE(PG8_SA(0, 0), cA, voffA); PG8_STAGE(PG8_SB(0, 1), cB + hstep, voffB); PG8_STAGE(PG8_SA(0, 1), cA + hstep, voffA);
        if (wr == 1) PG8_BAR;
        PG8_WAIT_V(4); PG8_BAR;
        PG8_STAGE(PG8_SB(1, 0), cB + kstep, voffB); PG8_STAGE(PG8_SA(1, 0), cA + kstep, voffA); PG8_STAGE(PG8_SB(1, 1), cB + hstep + kstep, voffB);
        PG8_WAIT_V(6); PG8_BAR;
    }
    for (;;) {
        const bool has_next = S.next(ui + 1, nxt);
        const char* nA = has_next ? (const char*)g.A + (size_t)nxt.pm * tstep : cA; const char* nB = has_next ? (const char*)g.Bt + (size_t)nxt.pn * tstep : cB;
        for (int t = 0; t < nt; t += 2) {
            const bool last = (t == nt - 2);
            const char* a1 = cA + (size_t)(t + 1) * kstep;
            const char* a2 = last ? nA : cA + (size_t)(t + 2) * kstep; const char* b2 = last ? nB : cB + (size_t)(t + 2) * kstep;
            const char* a3 = a2 + kstep; const char* b3 = b2 + kstep;
            if (last && has_next) S.a_ready(nxt);
            if constexpr (SP2) {
            PG8_LDB(B0, 0, 0); PG8_LDB(B1, 0, 1); PG8_SCHED; PG8_LDA(At, 0, 0); PG8_STAGE(PG8_SA(1, 1), a1 + hstep, voffA);
            PG8_WAIT_V(8); PG8_WAIT_L(0); PG8_BAR; PG8_MMA(0, 0, At, B0); PG8_MMA(0, 1, At, B1); PG8_BAR; PG8_SCHED;
            PG8_LDA(At, 0, 1); PG8_STAGE(PG8_SB(0, 0), b2, voffB); PG8_STAGE(PG8_SB(0, 1), b2 + hstep, voffB); PG8_STAGE(PG8_SA(0, 0), a2, voffA);
            PG8_WAIT_V(8); PG8_WAIT_L(0); PG8_BAR; PG8_MMA(1, 0, At, B0); PG8_MMA(1, 1, At, B1); PG8_BAR; PG8_SCHED;
            PG8_LDB(B0, 1, 0); PG8_LDB(B1, 1, 1); PG8_SCHED; PG8_LDA(At, 1, 0); PG8_STAGE(PG8_SA(0, 1), a2 + hstep, voffA);
            PG8_WAIT_V(8); PG8_WAIT_L(0); PG8_BAR; PG8_MMA(0, 0, At, B0); PG8_MMA(0, 1, At, B1); PG8_BAR; PG8_SCHED;
            PG8_LDA(At, 1, 1); PG8_STAGE(PG8_SB(1, 0), b3, voffB); PG8_STAGE(PG8_SB(1, 1), b3 + hstep, voffB); PG8_STAGE(PG8_SA(1, 0), a3, voffA);
            PG8_WAIT_V(8); PG8_WAIT_L(0); PG8_BAR; PG8_MMA(1, 0, At, B0); PG8_MMA(1, 1, At, B1); PG8_BAR; PG8_SCHED;
            } else {
            PG8_LDB(B0, 0, 0); PG8_SCHED; PG8_LDA(At, 0, 0); PG8_STAGE(PG8_SA(1, 1), a1 + hstep, voffA);
            PG8_WAIT_L(8); PG8_BAR; PG8_WAIT_L(0); PG8_MMA(0, 0, At, B0); PG8_BAR; PG8_SCHED;
            PG8_LDB(B1, 0, 1); PG8_STAGE(PG8_SB(0, 0), b2, voffB);
            PG8_BAR; PG8_WAIT_L(0); PG8_MMA(0, 1, At, B1); PG8_BAR;
            PG8_LDA(At, 0, 1); PG8_STAGE(PG8_SA(0, 0), a2, voffA);
            PG8_BAR; PG8_WAIT_L(0); PG8_MMA(1, 0, At, B0); PG8_BAR; PG8_SCHED;
            PG8_STAGE(PG8_SB(0, 1), b2 + hstep, voffB);
            PG8_WAIT_V(6); PG8_BAR; PG8_MMA(1, 1, At, B1); PG8_BAR;
            PG8_LDB(B0, 1, 0); PG8_SCHED; PG8_LDA(At, 1, 0); PG8_STAGE(PG8_SA(0, 1), a2 + hstep, voffA);
            PG8_WAIT_L(8); PG8_BAR; PG8_WAIT_L(0); PG8_MMA(0, 0, At, B0); PG8_BAR; PG8_SCHED;
            PG8_LDB(B1, 1, 1); PG8_STAGE(PG8_SB(1, 0), b3, voffB);
            PG8_BAR; PG8_WAIT_L(0); PG8_MMA(0, 1, At, B1); PG8_BAR;
            PG8_LDA(At, 1, 1); PG8_STAGE(PG8_SA(1, 0), a3, voffA);
            PG8_BAR; PG8_WAIT_L(0); PG8_MMA(1, 0, At, B0); PG8_BAR; PG8_SCHED;
            PG8_STAGE(PG8_SB(1, 1), b3 + hstep, voffB);
            PG8_WAIT_V(6); PG8_BAR; PG8_MMA(1, 1, At, B1); PG8_BAR;
            }
        }
        if constexpr (ALIGN_EPI) { if (wr == 0) PG8_BAR; }
        E(acc, cur, wr, wc, fr, fq); S.done(cur);
        if (!has_next) break;
#pragma unroll
        for (int a = 0; a < 2; ++a)
#pragma unroll
            for (int b = 0; b < 2; ++b)
#pragma unroll
                for (int m = 0; m < 4; ++m)
#pragma unroll
                    for (int n = 0; n < 2; ++n) acc[a][b][m][n] = (f32x4){0.f, 0.f, 0.f, 0.f};
        cur = nxt; cA = nA; cB = nB; ++ui;
        if constexpr (ALIGN_EPI) { if (wr == 1) PG8_BAR; }
    }
    PG8_WAIT_V(0);
    if constexpr (!ALIGN_EPI) { if (wr == 0) PG8_BAR; }
    PG8_BAR;
#undef PG8_SA
#undef PG8_SB
#undef PG8_STAGE
#undef PG8_LDA
#undef PG8_LDB
#undef PG8_MMA
#undef PG8_WAIT_V
#undef PG8_WAIT_L
#undef PG8_BAR
#undef PG8_SCHED
}
}

#define XB_TMO      128
#define XB_XCNT(j)  (256  + 64 * (j))
#define XB_XSUB(j)  (1280 + 64 * (j))
#define XB_XGEN(j)  (2304 + 64 * (j))
#define XB_TOP      3328
#define XB_TOPGEN   3392
#define XCD_BAR_WORDS 3456
#define XB_SPIN_CAP (1u << 18)
__device__ __forceinline__ unsigned xb_ld(unsigned* p)              { return __hip_atomic_load(p, __ATOMIC_RELAXED, __HIP_MEMORY_SCOPE_AGENT); }
__device__ __forceinline__ unsigned xb_add(unsigned* p, unsigned v) { return __hip_atomic_fetch_add(p, v, __ATOMIC_RELAXED, __HIP_MEMORY_SCOPE_AGENT); }
__device__ __forceinline__ unsigned xb_xcc_id() { return (unsigned)__builtin_amdgcn_s_getreg((3 << 11) | 20) & 0xFu; }
#define XB_SPIN(cond, bar) do { unsigned _sp = 0; while (cond) { __builtin_amdgcn_s_sleep(1); \
    if ((++_sp & 255u) == 0u) { if (xb_ld(&(bar)[XB_TMO])) break; if (_sp > XB_SPIN_CAP) { atomicAdd(&(bar)[XB_TMO], 1u); break; } } } } while (0)
struct XcdBarrier { unsigned* bar; unsigned x; volatile LAS unsigned* st; };
__device__ __forceinline__ XcdBarrier xcd_barrier_post(unsigned* bar, volatile LAS unsigned* st) {
    XcdBarrier b; b.bar = bar; b.x = xb_xcc_id(); b.st = st;
    if (threadIdx.x == 0) (void)xb_add(&bar[XB_XCNT(b.x)], 1u);
    return b;
}
__device__ __forceinline__ void xcd_barrier_complete(unsigned* bar, unsigned x, unsigned& nloc, unsigned& nx) {
    const unsigned G = gridDim.x * gridDim.y * gridDim.z;
    unsigned sum, cnt, mine, sp = 0u;
    for (;;) {
        sum = 0u; cnt = 0u; mine = 0u;
#pragma unroll
        for (unsigned j = 0; j < 16; ++j) { const unsigned c = xb_ld(&bar[XB_XCNT(j)]); sum += c; cnt += (c > 0u) ? 1u : 0u; mine = (j == x) ? c : mine; }
        if (sum == G) break;
        __builtin_amdgcn_s_sleep(1);
        if ((++sp & 255u) == 0u) { if (xb_ld(&bar[XB_TMO])) break; if (sp > XB_SPIN_CAP) { atomicAdd(&bar[XB_TMO], 1u); break; } }
    }
    nloc = mine > 0u ? mine : 1u; nx = cnt > 0u ? cnt : 1u;
}
__device__ __forceinline__ void xcd_barrier(const XcdBarrier& b) {
    asm volatile("s_waitcnt vmcnt(0)" ::: "memory");
    __syncthreads();
    if (threadIdx.x == 0) {
        unsigned* bar = b.bar;
        __builtin_amdgcn_s_waitcnt(0);
        unsigned nloc = b.st[0], nx = b.st[1];
        if (nloc == 0u) { xcd_barrier_complete(bar, b.x, nloc, nx); b.st[0] = nloc; b.st[1] = nx; }
        const unsigned old = xb_add(&bar[XB_XSUB(b.x)], 1u);
        const unsigned gen = old / nloc;
        if (old + 1u == (gen + 1u) * nloc) {
            __builtin_amdgcn_fence(__ATOMIC_RELEASE, "agent");
            asm volatile("s_waitcnt vmcnt(0)" ::: "memory");
            const unsigned og = xb_add(&bar[XB_TOP], 1u);
            const unsigned tg = og / nx;
            if (og + 1u == (tg + 1u) * nx) xb_add(&bar[XB_TOPGEN], 1u);
            else XB_SPIN(xb_ld(&bar[XB_TOPGEN]) == tg, bar);
            __builtin_amdgcn_fence(__ATOMIC_ACQUIRE, "agent");
            xb_add(&bar[XB_XGEN(b.x)], 1u);
            asm volatile("s_waitcnt vmcnt(0)" ::: "memory");
        } else {
            XB_SPIN(xb_ld(&bar[XB_XGEN(b.x)]) == gen, bar);
            __builtin_amdgcn_fence(__ATOMIC_ACQUIRE, "agent");
            asm volatile("s_waitcnt vmcnt(0)" ::: "memory");
        }
    }
    __syncthreads();
}

constexpr int T = 16384, SEQ = 4096, NB = 4, D = 2048, DIN = 3920, NZ = 4096;
constexpr int NE = 32;
constexpr int MPAD = 40960;
constexpr float EPS = 1e-6f;
constexpr int NWAVES = 8, NTHR = 512;
constexpr size_t MiB = 1u << 20;
constexpr size_t WS_CTL = 0, CTL_ZERO_BYTES = 1 * MiB;
constexpr int CW_BAR = 4096;
constexpr int CW_ECNT = 8192;
constexpr size_t WS_MOD = 512 * 1024;
constexpr size_t WS_WIN = 2 * MiB, WS_WQ = 34 * MiB, WS_WOUT = 40 * MiB, WS_WR = 64 * MiB, WS_WGU = 66 * MiB, WS_WD = 322 * MiB;
constexpr size_t WS_H = 450 * MiB, WS_ZF = 514 * MiB, WS_ZB = 578 * MiB, WS_CQN = 674 * MiB, WS_CKVN = 690 * MiB, WS_KIDX = 698 * MiB;
constexpr size_t WS_QLAT = 700 * MiB, WS_QIDX = 764 * MiB, WS_AO = 780 * MiB, WS_X1 = 876 * MiB, WS_X2 = 1004 * MiB;
constexpr size_t WS_GATE = 1132 * MiB, WS_CT = 1134 * MiB, WS_NS = 1198 * MiB, WS_XS = 1200 * MiB, WS_ACT = 1360 * MiB, WS_YS = 1400 * MiB, WS_RT = 1560 * MiB, WS_IDXL = 1562 * MiB, WS_END = 1572 * MiB;
constexpr size_t GATE_GA = 0, GATE_GMX = 262144, GATE_GB = 524288, GATE_MINS = 786432;
constexpr size_t RT_EIDX = 0, RT_GATE = 131072, RT_RANK = 262144, RT_TOKPOS = 393216, RT_ROWGATE = 524288, RT_TILEE = 524288 + 163840, RT_NT = RT_TILEE + 1024;
constexpr int LDS_BYTES = 147456;
constexpr int MISC_OFF = 140 * 1024;

struct Args { const float* in[22]; float* out; unsigned char* ws; int ph_lo, ph_hi; };

struct Frame {
    LAS unsigned char* lds;
    int tid, lane, wave, G;
    unsigned char* ws;
    const char __attribute__((address_space(4)))* ka;
};

__device__ __forceinline__ int rowmap_win(int n) {
    if (n < 768) return n;
    if (n < 832) return 3840 + (n - 768);
    if (n < 840) return 3904 + (n - 832);
    if (n < 3912) return 768 + (n - 840);
    return 3912 + (n - 3912);
}
__device__ __forceinline__ int rowmap_gu(int n) { return n < 512 ? ((n >> 7) * 256 + (n & 127)) : (((n - 512) >> 7) * 256 + 128 + ((n - 512) & 127)); }

template <int RM>
__device__ __forceinline__ void tr_item(const float* __restrict__ W, int ldw, int nmax, int k0, int n0, bf16* WT, int ldt, int kdst0, LAS float* scr, int lane) {
    const int n4 = lane & 15, kq = lane >> 4; const bool okn = (n0 + 4 * n4) < nmax;
#pragma unroll 8
    for (int i = 0; i < 16; ++i) { const int kk = 4 * i + kq; f32x4 v = (f32x4){0.f, 0.f, 0.f, 0.f};
        if (okn) v = __builtin_nontemporal_load((const f32x4*)(W + (size_t)(k0 + kk) * ldw + n0 + 4 * n4));
        LAS float* d = scr + kk * 65 + 4 * n4; d[0] = v.x; d[1] = v.y; d[2] = v.z; d[3] = v.w; }
    LDS_WAIT(); asm volatile("" ::: "memory");
    const int c = lane & 7;
#pragma unroll
    for (int j = 0; j < 8; ++j) { const int n = (lane >> 3) + 8 * j; const LAS float* s = scr + (8 * c) * 65 + n;
        v4u o; o.x = cvt_pk_bf16(s[0 * 65], s[1 * 65]); o.y = cvt_pk_bf16(s[2 * 65], s[3 * 65]); o.z = cvt_pk_bf16(s[4 * 65], s[5 * 65]); o.w = cvt_pk_bf16(s[6 * 65], s[7 * 65]);
        const int ng = n0 + n; const int row = RM == 1 ? rowmap_win(ng) : (RM == 2 ? rowmap_gu(ng) : ng);
        if (ng < nmax) *(v4u*)(WT + (size_t)row * ldt + kdst0 + k0 + 8 * c) = o; }
    LDS_WAIT(); asm volatile("" ::: "memory");
}

template <bool QT>
__device__ __forceinline__ void fold_item(const float* __restrict__ P, int ps, const float* __restrict__ Q, int qs, bf16* dst, int ldd, float scale, LAS float* Ps, LAS float* Qs, int tid) {
    __syncthreads();
#pragma unroll 4
    for (int it = 0; it < 16; ++it) { const int idx = it * 512 + tid; const int r = idx >> 7, d = idx & 127; Ps[r * 129 + d] = P[(size_t)r * ps + d]; }
    if (!QT) {
#pragma unroll 4
        for (int it = 0; it < 16; ++it) { const int idx = it * 512 + tid; const int r = idx >> 7, d = idx & 127; Qs[r * 129 + d] = Q[(size_t)r * qs + d]; }
    } else {
#pragma unroll 4
        for (int it = 0; it < 16; ++it) { const int idx = it * 512 + tid; const int d = idx >> 6, j = idx & 63; Qs[j * 129 + d] = Q[(size_t)d * qs + j]; }
    }
    __syncthreads();
    const int i = tid & 63, j0 = (tid >> 6) * 8;
    float a[8];
#pragma unroll
    for (int jj = 0; jj < 8; ++jj) a[jj] = 0.f;
#pragma unroll 4
    for (int d = 0; d < 128; ++d) { const float p = Ps[i * 129 + d];
#pragma unroll
        for (int jj = 0; jj < 8; ++jj) a[jj] += p * Qs[(j0 + jj) * 129 + d]; }
#pragma unroll
    for (int jj = 0; jj < 8; ++jj) { const unsigned u = cvt_pk_bf16(a[jj] * scale, 0.f); dst[(size_t)(j0 + jj) * ldd + i] = (bf16)(u & 0xffffu); }
}

#define AIN(i) (*(const float* const __attribute__((address_space(4)))*)(F.ka + 8 * (i)))
__device__ __forceinline__ void p0_prologue(Frame& F) {
    const float* c = AIN(1); const float* ada_w = AIN(2); const float* ada_b = AIN(3);
    const float* w_in = AIN(5); const float* w_uq = AIN(8); const float* w_uk = AIN(9); const float* w_uv = AIN(10); const float* w_qidx = AIN(11);
    const float* w_out = AIN(15); const float* router_w = AIN(17); const float* w_gu = AIN(19); const float* w_dn = AIN(20);
    bf16* WIN = (bf16*)(F.ws + WS_WIN); bf16* WQ = (bf16*)(F.ws + WS_WQ); bf16* WOUT = (bf16*)(F.ws + WS_WOUT); bf16* WR = (bf16*)(F.ws + WS_WR);
    bf16* WGU = (bf16*)(F.ws + WS_WGU); bf16* WD = (bf16*)(F.ws + WS_WD); float* MOD = (float*)(F.ws + WS_MOD);
    const int gw = blockIdx.x * NWAVES + F.wave, NGW = F.G * NWAVES;
    __syncthreads();
    {
        LAS float* cs = (LAS float*)(F.lds);
        for (int i = F.tid; i < NB * D; i += NTHR) { const float v = c[i]; cs[i] = v / (1.f + __expf(-v)); }
        __syncthreads();
        constexpr int NCG = 12288 / 128, NTASK = 2 * NCG;
        typedef float f32x2 __attribute__((ext_vector_type(2)));
        LAS float* red = (LAS float*)(F.lds + 32768);
        for (int task = blockIdx.x; task < NTASK; task += F.G) {
            const int cg = task % NCG, l = task / NCG;
            const int n = cg * 128 + F.lane * 2, k0 = F.wave * 256;
            const float* wp = ada_w + ((size_t)l * D + k0) * 12288 + n;
            f32x2 acc[4];
#pragma unroll
            for (int b = 0; b < 4; ++b) acc[b] = (f32x2){0.f, 0.f};
#pragma unroll 8
            for (int k = 0; k < 256; ++k) { const f32x2 w = *(const f32x2*)(wp + (size_t)k * 12288);
#pragma unroll
                for (int b = 0; b < 4; ++b) acc[b] += w * cs[b * D + k0 + k]; }
            __syncthreads();
#pragma unroll
            for (int b = 0; b < 4; ++b) { red[(F.wave * 4 + b) * 128 + F.lane * 2] = acc[b].x; red[(F.wave * 4 + b) * 128 + F.lane * 2 + 1] = acc[b].y; }
            __syncthreads();
            { const int b = F.tid >> 7, c = F.tid & 127; float sum = ada_b[(size_t)l * 12288 + cg * 128 + c];
#pragma unroll
              for (int w8 = 0; w8 < 8; ++w8) sum += red[(w8 * 4 + b) * 128 + c];
              MOD[((size_t)l * 4 + b) * 12288 + cg * 128 + c] = sum; }
        }
        __syncthreads();
    }
    {
        LAS float* Ps = (LAS float*)(F.lds); LAS float* Qs = Ps + 64 * 129;
        constexpr int NQL = 2 * 8 * 8 * 4, NOV = 2 * 8 * 4 * 32;
        for (int it = blockIdx.x; it < NQL + NOV; it += F.G) {
            if (it < NQL) { const int jt = it & 3, itl = (it >> 2) & 7, h = (it >> 5) & 7, l = it >> 8;
                fold_item<false>(w_uq + (size_t)l * 512 * 1024 + (size_t)(itl * 64) * 1024 + h * 128, 1024, w_uk + (size_t)l * 256 * 1024 + (size_t)(jt * 64) * 1024 + h * 128, 1024,
                                 WQ + (size_t)l * 2560 * 512 + (size_t)(h * 256 + jt * 64) * 512 + itl * 64, 512, 0.08838834764831845f * 1.4426950408889634f, Ps, Qs, F.tid);
            } else { const int r = it - NQL; const int jt = r & 31, itl = (r >> 5) & 3, h = (r >> 7) & 7, l = r >> 10;
                fold_item<true>(w_uv + (size_t)l * 256 * 1024 + (size_t)(itl * 64) * 1024 + h * 128, 1024, w_out + (size_t)l * 2048 * 2048 + (size_t)(h * 128) * 2048 + jt * 64, 2048,
                                WOUT + (size_t)l * 2048 * 3072 + (size_t)(jt * 64) * 3072 + h * 256 + itl * 64, 3072, 1.0f, Ps, Qs, F.tid);
            }
        }
        __syncthreads();
    }
    {
        LAS float* scr = (LAS float*)(F.lds + F.wave * 16896);
        constexpr int NB_WIN = 62, I_WIN = 32 * NB_WIN, I_QI = 8 * 8, I_WO = 16 * 32, I_R = 32 * 1, I_GU = 32 * 16, I_DN = 8 * 32;
        constexpr int NIT = 2 * I_WIN + 2 * I_QI + 2 * I_WO + I_R + 64 * I_GU + 64 * I_DN;
        for (int it = gw; it < NIT; it += NGW) {
            int r = it;
            if (r < 64 * I_GU) { const int le = r / I_GU; r %= I_GU; const int kb = r / 16, nb = r % 16;
                tr_item<2>(w_gu + (size_t)le * 2048 * 1024, 1024, 1024, kb * 64, nb * 64, WGU + (size_t)le * 1024 * 2048, 2048, 0, scr, F.lane); continue; } r -= 64 * I_GU;
            if (r < 64 * I_DN) { const int le = r / I_DN; r %= I_DN; const int kb = r / 32, nb = r % 32;
                tr_item<0>(w_dn + (size_t)le * 512 * 2048, 2048, 2048, kb * 64, nb * 64, WD + (size_t)le * 2048 * 512, 512, 0, scr, F.lane); continue; } r -= 64 * I_DN;
            if (r < 2 * I_WIN) { const int l = r / I_WIN; r %= I_WIN; const int kb = r / NB_WIN, nb = r % NB_WIN;
                tr_item<1>(w_in + (size_t)l * D * DIN, DIN, DIN, kb * 64, nb * 64, WIN + (size_t)l * NZ * D, D, 0, scr, F.lane); continue; } r -= 2 * I_WIN;
            if (r < 2 * I_QI) { const int l = r / I_QI; r %= I_QI; const int kb = r / 8, nb = r % 8;
                tr_item<0>(w_qidx + (size_t)l * 512 * 512, 512, 512, kb * 64, nb * 64, WQ + (size_t)l * 2560 * 512 + (size_t)2048 * 512, 512, 0, scr, F.lane); continue; } r -= 2 * I_QI;
            if (r < 2 * I_WO) { const int l = r / I_WO; r %= I_WO; const int kb = r / 32, nb = r % 32;
                tr_item<0>(w_out + (size_t)l * 2048 * 2048 + (size_t)1024 * 2048, 2048, 2048, kb * 64, nb * 64, WOUT + (size_t)l * 2048 * 3072, 3072, 2048, scr, F.lane); continue; } r -= 2 * I_WO;
            tr_item<0>(router_w, 32, 32, r * 64, 0, WR, 2048, 0, scr, F.lane);
        }
    }
}

__device__ __forceinline__ void norm_phase(Frame& F, const float* __restrict__ xin, const float* __restrict__ gain, const float* __restrict__ sc, const float* __restrict__ sh, bf16* H) {
    const int gw = blockIdx.x * NWAVES + F.wave, NGW = F.G * NWAVES;
    for (int rb = gw; rb < T / 8; rb += NGW) {
        const int r0 = rb * 8, b = r0 / SEQ;
        f32x4 ga[8], be[8];
#pragma unroll
        for (int j = 0; j < 8; ++j) { const int col = 4 * F.lane + 256 * j; const f32x4 g = *(const f32x4*)(gain + col), s = *(const f32x4*)(sc + (size_t)b * 12288 + col);
            ga[j] = g * (s + 1.0f); be[j] = *(const f32x4*)(sh + (size_t)b * 12288 + col); }
        for (int r = r0; r < r0 + 8; ++r) {
            const f32x4* xr = (const f32x4*)(xin + (size_t)r * D) + F.lane;
            f32x4 v[8]; float s = 0.f;
#pragma unroll
            for (int j = 0; j < 8; ++j) { v[j] = xr[64 * j]; s += (v[j].x * v[j].x + v[j].y * v[j].y) + (v[j].z * v[j].z + v[j].w * v[j].w); }
            const float rstd = 1.0f / sqrtf(wave_sum(s) * (1.f / D) + EPS);
            v2u* o = (v2u*)(H + (size_t)r * D) + F.lane;
#pragma unroll
            for (int j = 0; j < 8; ++j) { const f32x4 y = v[j] * rstd * ga[j] + be[j]; v2u w; w.x = cvt_pk_bf16(y.x, y.y); w.y = cvt_pk_bf16(y.z, y.w); o[64 * j] = w; }
        }
    }
}
__device__ __forceinline__ void combine_phase(Frame& F, int l, const float* __restrict__ X1, const float* __restrict__ g2, const bf16* __restrict__ YS, const int* __restrict__ tokpos,
                                              float* X2, const float* __restrict__ gain, const float* __restrict__ sc, const float* __restrict__ sh, bf16* H, float* out) {
    const int gw = blockIdx.x * NWAVES + F.wave, NGW = F.G * NWAVES;
    for (int rb = gw; rb < T / 8; rb += NGW) {
        const int r0 = rb * 8, b = r0 / SEQ;
        for (int r = r0; r < r0 + 8; ++r) {
            const int p0 = tokpos[2 * r], p1 = tokpos[2 * r + 1];
            const f32x4* xr = (const f32x4*)(X1 + (size_t)r * D) + F.lane;
            const v2u* y0 = (const v2u*)(YS + (size_t)p0 * D) + F.lane; const v2u* y1 = (const v2u*)(YS + (size_t)p1 * D) + F.lane;
            f32x4 v[8]; float s = 0.f;
#pragma unroll
            for (int j = 0; j < 8; ++j) { const int col = 4 * F.lane + 256 * j; const f32x4 g = *(const f32x4*)(g2 + (size_t)b * 12288 + col);
                const v2u a = y0[64 * j], c = y1[64 * j];
                f32x4 ys; ys.x = bf_lo(a.x) + bf_lo(c.x); ys.y = bf_hi(a.x) + bf_hi(c.x); ys.z = bf_lo(a.y) + bf_lo(c.y); ys.w = bf_hi(a.y) + bf_hi(c.y);
                v[j] = xr[64 * j] + g * ys; s += (v[j].x * v[j].x + v[j].y * v[j].y) + (v[j].z * v[j].z + v[j].w * v[j].w); }
            const float rstd = 1.0f / sqrtf(wave_sum(s) * (1.f / D) + EPS);
            if (l == 0) {
                f32x4* xo = (f32x4*)(X2 + (size_t)r * D) + F.lane; v2u* o = (v2u*)(H + (size_t)r * D) + F.lane;
#pragma unroll
                for (int j = 0; j < 8; ++j) { const int col = 4 * F.lane + 256 * j; xo[64 * j] = v[j];
                    const f32x4 g = *(const f32x4*)(gain + col), s1 = *(const f32x4*)(sc + (size_t)b * 12288 + col), h1 = *(const f32x4*)(sh + (size_t)b * 12288 + col);
                    const f32x4 y = v[j] * rstd * g * (s1 + 1.0f) + h1; v2u w; w.x = cvt_pk_bf16(y.x, y.y); w.y = cvt_pk_bf16(y.z, y.w); o[64 * j] = w; }
            } else {
                f32x4* oo = (f32x4*)(out + (size_t)r * D) + F.lane;
#pragma unroll
                for (int j = 0; j < 8; ++j) { const int col = 4 * F.lane + 256 * j; const f32x4 g = *(const f32x4*)(gain + col); oo[64 * j] = v[j] * rstd * g; }
            }
        }
    }
}

struct EpiZ {
    static constexpr bool PERM = true;
    float* ZF; bf16* ZB;
    __device__ __forceinline__ void operator()(const f32x4 (&acc)[2][2][4][2], const pg8::Unit& u, int wr, int wc, int fr, int fq) const {
        const int row0 = u.pm * 256 + wr * 64 + fr, cl = wc * 32 + 8 * fq;
        if (u.pn <= 2 || u.pn == 15) {
            const int cb = (u.pn == 15 ? 768 : u.pn * 256) + cl;
#pragma unroll
            for (int ai = 0; ai < 2; ++ai)
#pragma unroll
                for (int m = 0; m < 4; ++m) { float* rp = ZF + (size_t)(row0 + ai * 128 + m * 16) * 1024 + cb;
#pragma unroll
                    for (int bj = 0; bj < 2; ++bj) { *(f32x4*)(rp + bj * 128) = acc[ai][bj][m][0]; *(f32x4*)(rp + bj * 128 + 4) = acc[ai][bj][m][1]; } }
        } else {
            const int cb = (u.pn - 3) * 256 + cl;
#pragma unroll
            for (int ai = 0; ai < 2; ++ai)
#pragma unroll
                for (int m = 0; m < 4; ++m) { bf16* rp = ZB + (size_t)(row0 + ai * 128 + m * 16) * 3072 + cb;
#pragma unroll
                    for (int bj = 0; bj < 2; ++bj) { const f32x4 v0 = acc[ai][bj][m][0], v1 = acc[ai][bj][m][1]; v4u w;
                        w.x = cvt_pk_bf16(v0[0], v0[1]); w.y = cvt_pk_bf16(v0[2], v0[3]); w.z = cvt_pk_bf16(v1[0], v1[1]); w.w = cvt_pk_bf16(v1[2], v1[3]); *(v4u*)(rp + bj * 128) = w; } }
        }
    }
};
struct EpiQ {
    static constexpr bool PERM = true;
    bf16* QLAT; bf16* QIDX;
    __device__ __forceinline__ void operator()(const f32x4 (&acc)[2][2][4][2], const pg8::Unit& u, int wr, int wc, int fr, int fq) const {
        const int row0 = u.pm * 256 + wr * 64 + fr, cl = wc * 32 + 8 * fq;
        bf16* base; int ld, cb;
        if (u.pn < 8) { base = QLAT; ld = 2048; cb = u.pn * 256 + cl; } else { base = QIDX; ld = 512; cb = (u.pn - 8) * 256 + cl; }
#pragma unroll
        for (int ai = 0; ai < 2; ++ai)
#pragma unroll
            for (int m = 0; m < 4; ++m) { bf16* rp = base + (size_t)(row0 + ai * 128 + m * 16) * ld + cb;
#pragma unroll
                for (int bj = 0; bj < 2; ++bj) { const f32x4 v0 = acc[ai][bj][m][0], v1 = acc[ai][bj][m][1]; v4u w;
                    w.x = cvt_pk_bf16(v0[0], v0[1]); w.y = cvt_pk_bf16(v0[2], v0[3]); w.z = cvt_pk_bf16(v1[0], v1[1]); w.w = cvt_pk_bf16(v1[2], v1[3]); *(v4u*)(rp + bj * 128) = w; } }
    }
};
struct EpiRes {
    static constexpr bool PERM = false;
    const float* Xin; float* X1; const float* g1;
    __device__ __forceinline__ void operator()(const f32x4 (&acc)[2][2][4][2], const pg8::Unit& u, int wr, int wc, int fr, int fq) const {
        const int row0 = u.pm * 256 + wr * 64 + fr, col0 = u.pn * 256 + wc * 32 + 4 * fq; const int b = (u.pm * 256) / SEQ;
        f32x4 gv[2][2];
#pragma unroll
        for (int bj = 0; bj < 2; ++bj)
#pragma unroll
            for (int n = 0; n < 2; ++n) gv[bj][n] = *(const f32x4*)(g1 + (size_t)b * 12288 + col0 + bj * 128 + n * 16);
#pragma unroll
        for (int ai = 0; ai < 2; ++ai)
#pragma unroll
            for (int m = 0; m < 4; ++m) { const size_t off = (size_t)(row0 + ai * 128 + m * 16) * D + col0;
#pragma unroll
                for (int bj = 0; bj < 2; ++bj)
#pragma unroll
                    for (int n = 0; n < 2; ++n) { const f32x4 xi = *(const f32x4*)(Xin + off + bj * 128 + n * 16); *(f32x4*)(X1 + off + bj * 128 + n * 16) = xi + gv[bj][n] * acc[ai][bj][m][n]; } }
    }
};
template <int NPN> struct MoeOrder {
    static constexpr int npn = NPN;
    const int* tile_e; int ntiles, G, c;
    __device__ __forceinline__ bool next(int i, pg8::Unit& u) const { const int L = i * G + c; if (L >= ntiles * npn) return false; const int tile = L / npn, pn = L % npn; u.pm = tile; u.pn = tile_e[tile] * npn + pn; return true; }
    __device__ __forceinline__ void a_ready(const pg8::Unit&) const {}
    __device__ __forceinline__ void done(const pg8::Unit&) const {}
};
struct EpiGU {
    static constexpr bool PERM = true;
    bf16* ACT;
    __device__ __forceinline__ void operator()(const f32x4 (&acc)[2][2][4][2], const pg8::Unit& u, int wr, int wc, int fr, int fq) const {
        const int row0 = u.pm * 256 + wr * 64 + fr, cb = (u.pn & 3) * 128 + wc * 32 + 8 * fq;
#pragma unroll
        for (int ai = 0; ai < 2; ++ai)
#pragma unroll
            for (int m = 0; m < 4; ++m) { float o[8];
#pragma unroll
                for (int n = 0; n < 2; ++n)
#pragma unroll
                    for (int e = 0; e < 4; ++e) { const float g = acc[ai][0][m][n][e], up = acc[ai][1][m][n][e]; o[n * 4 + e] = g / (1.f + __expf(-g)) * up; }
                v4u w; w.x = cvt_pk_bf16(o[0], o[1]); w.y = cvt_pk_bf16(o[2], o[3]); w.z = cvt_pk_bf16(o[4], o[5]); w.w = cvt_pk_bf16(o[6], o[7]);
                *(v4u*)(ACT + (size_t)(row0 + ai * 128 + m * 16) * 512 + cb) = w; }
    }
};
struct EpiDN {
    static constexpr bool PERM = true;
    bf16* YS; const float* rowgate;
    __device__ __forceinline__ void operator()(const f32x4 (&acc)[2][2][4][2], const pg8::Unit& u, int wr, int wc, int fr, int fq) const {
        const int row0 = u.pm * 256 + wr * 64 + fr, cb = (u.pn & 7) * 256 + wc * 32 + 8 * fq;
#pragma unroll
        for (int ai = 0; ai < 2; ++ai)
#pragma unroll
            for (int m = 0; m < 4; ++m) { const int r = row0 + ai * 128 + m * 16; const float gt = rowgate[r]; bf16* rp = YS + (size_t)r * D + cb;
#pragma unroll
                for (int bj = 0; bj < 2; ++bj) { const f32x4 v0 = acc[ai][bj][m][0] * gt, v1 = acc[ai][bj][m][1] * gt; v4u w;
                    w.x = cvt_pk_bf16(v0[0], v0[1]); w.y = cvt_pk_bf16(v0[2], v0[3]); w.z = cvt_pk_bf16(v1[0], v1[1]); w.w = cvt_pk_bf16(v1[2], v1[3]); *(v4u*)(rp + bj * 128) = w; } }
    }
};

__device__ __forceinline__ float wave_scan_add(float v, int lane) {
#pragma unroll
    for (int o = 1; o < 64; o <<= 1) { const float t = __shfl_up(v, o); if (lane >= o) v += t; }
    return v;
}
__device__ __forceinline__ float wave_scan_max(float v, int lane) {
#pragma unroll
    for (int o = 1; o < 64; o <<= 1) { const float t = __shfl_up(v, o); if (lane >= o) v = fmaxf(v, t); }
    return v;
}
__device__ __forceinline__ void p3_phase(Frame& F, const float* __restrict__ ZF, const float* __restrict__ gq, const float* __restrict__ gkv, const float* __restrict__ ib, const float* __restrict__ fb,
                                         bf16* CQN, bf16* CKVN, bf16* KIDX, float* GA, float* GMX, float* GB, float* MINS) {
    const int gw = blockIdx.x * NWAVES + F.wave, NGW = F.G * NWAVES;
    for (int chain = gw; chain < 16 * NWAVES; chain += NGW) {
        if ((chain & 7) != 0) continue;
        const int ch = chain >> 3, b = ch >> 2, h = ch & 3; const float ibias = ib[h], fbias = fb[h];
        float m_in = 0.f;
        for (int k0 = 0; k0 < 64; k0 += 8) {
            float miv[8], mfv[8];
#pragma unroll
            for (int u = 0; u < 8; ++u) { const int t = b * SEQ + 64 * (k0 + u) + F.lane; miv[u] = ZF[(size_t)t * 1024 + 768 + 72 + h]; mfv[u] = ZF[(size_t)t * 1024 + 768 + 76 + h]; }
#pragma unroll
            for (int u = 0; u < 8; ++u) {
                const int k = k0 + u, t = b * SEQ + 64 * k + F.lane;
                const float mi = miv[u] + ibias, mf = mfv[u] + fbias;
                const float lf = fminf(mf, 0.f) - log1pf(__expf(-fabsf(mf)));
                const float bj = wave_scan_add(lf, F.lane);
                const float a = mi - bj;
                const float mx = fmaxf(m_in, wave_scan_max(a, F.lane));
                GA[t * 4 + h] = a; GMX[t * 4 + h] = mx; GB[t * 4 + h] = bj;
                if (F.lane == 0) MINS[ch * 65 + k] = m_in;
                m_in = __shfl(bj, 63) + __shfl(mx, 63);
            }
        }
        if (F.lane == 0) MINS[ch * 65 + 64] = m_in;
    }
    for (int rb = gw; rb < T / 8; rb += NGW) {
        const f32x4 g0 = *(const f32x4*)(gq + 4 * F.lane), g1 = *(const f32x4*)(gq + 256 + 4 * F.lane), g2 = *(const f32x4*)(gkv + 4 * F.lane);
        for (int r = rb * 8; r < rb * 8 + 8; ++r) {
            const float* zr = ZF + (size_t)r * 1024;
            const f32x4 a0 = *(const f32x4*)(zr + 4 * F.lane), a1 = *(const f32x4*)(zr + 256 + 4 * F.lane), kv = *(const f32x4*)(zr + 512 + 4 * F.lane);
            const float ki = zr[768 + F.lane];
            float s1 = (a0.x * a0.x + a0.y * a0.y) + (a0.z * a0.z + a0.w * a0.w) + (a1.x * a1.x + a1.y * a1.y) + (a1.z * a1.z + a1.w * a1.w);
            float s2 = (kv.x * kv.x + kv.y * kv.y) + (kv.z * kv.z + kv.w * kv.w);
            const float r1 = 1.0f / sqrtf(wave_sum(s1) * (1.f / 512.f) + EPS), r2 = 1.0f / sqrtf(wave_sum(s2) * (1.f / 256.f) + EPS);
            const f32x4 y0 = a0 * r1 * g0, y1 = a1 * r1 * g1, y2 = kv * r2 * g2;
            v2u w; w.x = cvt_pk_bf16(y0.x, y0.y); w.y = cvt_pk_bf16(y0.z, y0.w); *((v2u*)(CQN + (size_t)r * 512) + F.lane) = w;
            w.x = cvt_pk_bf16(y1.x, y1.y); w.y = cvt_pk_bf16(y1.z, y1.w); *((v2u*)(CQN + (size_t)r * 512 + 256) + F.lane) = w;
            w.x = cvt_pk_bf16(y2.x, y2.y); w.y = cvt_pk_bf16(y2.z, y2.w); *((v2u*)(CKVN + (size_t)r * 256) + F.lane) = w;
            KIDX[(size_t)r * 64 + F.lane] = (bf16)(cvt_pk_bf16(ki, 0.f) & 0xffffu);
        }
    }
}

__device__ __forceinline__ unsigned off_b(unsigned row, unsigned ch) { return 256u * row + 16u * (ch ^ (((row & 3u) << 2) | ((row >> 2) & 3u))); }
__device__ __forceinline__ unsigned tr_addr16(unsigned lane, unsigned c, unsigned t) { const unsigned g = lane >> 4, q = (lane & 15u) >> 2, p = lane & 3u; return off_b(8u * g + 4u * t + q, 2u * c + (p >> 1)) + 8u * (p & 1u); }
__device__ __forceinline__ void tr_read8(const unsigned (&a)[8], v2u (&r)[8]) {
    asm volatile("ds_read_b64_tr_b16 %0, %8\n\tds_read_b64_tr_b16 %1, %9\n\tds_read_b64_tr_b16 %2, %10\n\tds_read_b64_tr_b16 %3, %11\n\t"
                 "ds_read_b64_tr_b16 %4, %12\n\tds_read_b64_tr_b16 %5, %13\n\tds_read_b64_tr_b16 %6, %14\n\tds_read_b64_tr_b16 %7, %15\n\ts_waitcnt lgkmcnt(0)"
                 : "=&v"(r[0]), "=&v"(r[1]), "=&v"(r[2]), "=&v"(r[3]), "=&v"(r[4]), "=&v"(r[5]), "=&v"(r[6]), "=&v"(r[7])
                 : "v"(a[0]), "v"(a[1]), "v"(a[2]), "v"(a[3]), "v"(a[4]), "v"(a[5]), "v"(a[6]), "v"(a[7]) : "memory");
}

__device__ __forceinline__ void tr_read4(const unsigned (&a)[4], v2u (&r)[4]) {
    asm volatile("ds_read_b64_tr_b16 %0, %4\n\tds_read_b64_tr_b16 %1, %5\n\tds_read_b64_tr_b16 %2, %6\n\tds_read_b64_tr_b16 %3, %7\n\ts_waitcnt lgkmcnt(0)"
                 : "=&v"(r[0]), "=&v"(r[1]), "=&v"(r[2]), "=&v"(r[3]) : "v"(a[0]), "v"(a[1]), "v"(a[2]), "v"(a[3]) : "memory");
}

#ifndef M1_RC
#define M1_RC 4
#endif
__device__ __forceinline__ void m1_scan(Frame& F, const bf16* __restrict__ ZB, const float* __restrict__ GA, const float* __restrict__ GMX, const float* __restrict__ MINS, bf16* CT, float* NS) {
    LAS unsigned char* kimg = F.lds; LAS bf16* vT = (LAS bf16*)(F.lds + 65536);
    const unsigned kbase = (unsigned)(size_t)kimg;
    const int g = F.lane >> 4, n = F.lane & 15, w = F.wave;
    for (int unit = blockIdx.x; unit < 256; unit += F.G) {
        const int chain = unit >> 4, sl = unit & 15, b = chain >> 2, h = chain & 3; const int bt0 = b * SEQ;
        const int s = F.tid >> 3, dc = F.tid & 7;
        f32x4 C = (f32x4){0.f, 0.f, 0.f, 0.f}, Nacc = (f32x4){0.f, 0.f, 0.f, 0.f};
        bf16x8 ones; for (int i = 0; i < 8; ++i) ones[i] = (short)0x3F80;
        v4u kr[M1_RC][2], vr[M1_RC]; float gav[M1_RC], gmv[M1_RC];
#define M1_PREFETCH(r) do { _Pragma("unroll") for (int c = 0; c < M1_RC; ++c) { const int k_ = M1_RC * (r) + c, t_ = bt0 + 64 * k_ + s; const bf16* kp = ZB + (size_t)t_ * 3072 + 512 + h * 128 + dc * 16; \
            kr[c][0] = *(const v4u*)kp; kr[c][1] = *(const v4u*)(kp + 8); \
            vr[c] = (v4u){0u, 0u, 0u, 0u}; if (F.tid < 128) vr[c] = *(const v4u*)(ZB + (size_t)(bt0 + 64 * k_ + (F.tid >> 1)) * 3072 + 1024 + h * 256 + sl * 16 + (F.tid & 1) * 8); \
            gav[c] = GA[t_ * 4 + h]; gmv[c] = GMX[(bt0 + 64 * k_ + 63) * 4 + h]; } } while (0)
        M1_PREFETCH(0);
        __syncthreads();
        for (int r = 0; r < 64 / M1_RC; ++r) {
            float w_old[M1_RC];
#pragma unroll
            for (int c = 0; c < M1_RC; ++c) {
                LAS bf16* vTb = vT + c * 16 * 72;
                const float wsc = __expf(gav[c] - gmv[c]);
                v4u o0, o1;
                o0.x = cvt_pk_bf16(bf_lo(kr[c][0].x) * wsc, bf_hi(kr[c][0].x) * wsc); o0.y = cvt_pk_bf16(bf_lo(kr[c][0].y) * wsc, bf_hi(kr[c][0].y) * wsc);
                o0.z = cvt_pk_bf16(bf_lo(kr[c][0].z) * wsc, bf_hi(kr[c][0].z) * wsc); o0.w = cvt_pk_bf16(bf_lo(kr[c][0].w) * wsc, bf_hi(kr[c][0].w) * wsc);
                o1.x = cvt_pk_bf16(bf_lo(kr[c][1].x) * wsc, bf_hi(kr[c][1].x) * wsc); o1.y = cvt_pk_bf16(bf_lo(kr[c][1].y) * wsc, bf_hi(kr[c][1].y) * wsc);
                o1.z = cvt_pk_bf16(bf_lo(kr[c][1].z) * wsc, bf_hi(kr[c][1].z) * wsc); o1.w = cvt_pk_bf16(bf_lo(kr[c][1].w) * wsc, bf_hi(kr[c][1].w) * wsc);
                LAS unsigned char* im = kimg + c * 16384 + (s >> 5) * 8192;
                *(LAS v4u*)(im + off_b((unsigned)(s & 31), 2u * dc)) = o0; *(LAS v4u*)(im + off_b((unsigned)(s & 31), 2u * dc + 1u)) = o1;
                if (F.tid < 128) { const unsigned vv[4] = {vr[c].x, vr[c].y, vr[c].z, vr[c].w}; const int vs = F.tid >> 1, e8 = (F.tid & 1) * 8;
#pragma unroll
                    for (int i = 0; i < 4; ++i) { vTb[(e8 + 2 * i) * 72 + vs] = (bf16)(vv[i] & 0xffffu); vTb[(e8 + 2 * i + 1) * 72 + vs] = (bf16)(vv[i] >> 16); } }
                w_old[c] = __expf(MINS[chain * 65 + M1_RC * r + c] - GMX[(bt0 + 64 * (M1_RC * r + c) + 63) * 4 + h]);
            }
            if (r + 1 < 64 / M1_RC) M1_PREFETCH(r + 1);
            __syncthreads();
#pragma unroll
            for (int c = 0; c < M1_RC; ++c) {
                const int k = M1_RC * r + c; LAS bf16* vTb = vT + c * 16 * 72;
                { bf16* cp = CT + ((size_t)(chain * 64 + k) * 256 + sl * 16 + 4 * g) * 128 + 16 * w + n;
#pragma unroll
                  for (int i = 0; i < 4; ++i) cp[(size_t)i * 128] = (bf16)(cvt_pk_bf16(C[i], 0.f) & 0xffffu);
                  if (sl == 0 && g == 0) NS[(size_t)(chain * 64 + k) * 128 + 16 * w + n] = Nacc[0]; }
                C = C * w_old[c]; Nacc = Nacc * w_old[c];
                {
                    const bf16x8 Af0 = *(const LAS bf16x8*)(vTb + n * 72 + 8 * g), Af1 = *(const LAS bf16x8*)(vTb + n * 72 + 32 + 8 * g);
                    unsigned ad[4]; v2u rr[4];
                    const unsigned cb = kbase + (unsigned)c * 16384u;
                    ad[0] = cb + tr_addr16((unsigned)F.lane, (unsigned)w, 0u); ad[1] = cb + tr_addr16((unsigned)F.lane, (unsigned)w, 1u);
                    ad[2] = ad[0] + 8192u; ad[3] = ad[1] + 8192u;
                    tr_read4(ad, rr);
                    v4u b0, b1; b0.x = rr[0].x; b0.y = rr[0].y; b0.z = rr[1].x; b0.w = rr[1].y; b1.x = rr[2].x; b1.y = rr[2].y; b1.z = rr[3].x; b1.w = rr[3].y;
                    const bf16x8 Bf0 = __builtin_bit_cast(bf16x8, b0), Bf1 = __builtin_bit_cast(bf16x8, b1);
                    C = __builtin_amdgcn_mfma_f32_16x16x32_bf16(Af0, Bf0, C, 0, 0, 0);
                    Nacc = __builtin_amdgcn_mfma_f32_16x16x32_bf16(ones, Bf0, Nacc, 0, 0, 0);
                    C = __builtin_amdgcn_mfma_f32_16x16x32_bf16(Af1, Bf1, C, 0, 0, 0);
                    Nacc = __builtin_amdgcn_mfma_f32_16x16x32_bf16(ones, Bf1, Nacc, 0, 0, 0);
                }
            }
            __syncthreads();
        }
#undef M1_PREFETCH
    }
}

__device__ __forceinline__ void m3_out(Frame& F, const bf16* __restrict__ ZB, const float* __restrict__ GA, const float* __restrict__ GMX, const float* __restrict__ GB, const float* __restrict__ MINS,
                                       const bf16* __restrict__ CT, const float* __restrict__ NS, const float* __restrict__ gn, bf16* AO) {
    LAS unsigned char* vimg = F.lds; LAS bf16* scT = (LAS bf16*)(F.lds + 32768);
    LAS float* qn = (LAS float*)(F.lds + 41984); LAS float* nin = (LAS float*)(F.lds + 42240);
    LAS float* denp = (LAS float*)(F.lds + 42752);
    LAS float* ssp = (LAS float*)(F.lds + 43776);
    const unsigned vbase = (unsigned)(size_t)vimg;
    const int g = F.lane >> 4, n = F.lane & 15, w = F.wave;
    const float qs = 0.08838834764831845f;
    for (int unit = blockIdx.x; unit < 1024; unit += F.G) {
        const int chain = unit >> 6, k = unit & 63, b = chain >> 2, h = chain & 3; const int t0 = b * SEQ + 64 * k;
        const int vs = F.tid >> 3, ec = F.tid & 7;
        v4u vr[4];
        { const bf16* vp = ZB + (size_t)(t0 + vs) * 3072 + 1024 + h * 256 + ec * 32;
#pragma unroll
          for (int q = 0; q < 4; ++q) vr[q] = *(const v4u*)(vp + 8 * q); }
        bf16x8 qf[4][4], kf[4], cf[2][4];
        const int st = w >> 1;
#pragma unroll
        for (int ks = 0; ks < 4; ++ks) {
#pragma unroll
            for (int jt = 0; jt < 4; ++jt) qf[jt][ks] = *(const bf16x8*)(ZB + (size_t)(t0 + 16 * jt + n) * 3072 + h * 128 + 32 * ks + 8 * g);
            kf[ks] = *(const bf16x8*)(ZB + (size_t)(t0 + 16 * st + n) * 3072 + 512 + h * 128 + 32 * ks + 8 * g);
#pragma unroll
            for (int mt = 0; mt < 2; ++mt) cf[mt][ks] = *(const bf16x8*)(CT + ((size_t)(chain * 64 + k) * 256 + 32 * w + 16 * mt + n) * 128 + 32 * ks + 8 * g);
        }
        const float nval = (F.tid < 128) ? NS[(size_t)(chain * 64 + k) * 128 + F.tid] : 0.f;
        const float m_in = MINS[chain * 65 + k];
        __syncthreads();
        {
#pragma unroll
            for (int q = 0; q < 4; ++q) *(LAS v4u*)(vimg + ((vs >> 5) * 2 + (ec >> 2)) * 8192 + off_b((unsigned)(vs & 31), 4u * (ec & 3) + q)) = vr[q];
            if (F.tid < 128) nin[F.tid] = nval;
        }
#pragma unroll
        for (int jt = 0; jt < 4; ++jt) if ((jt >> 1) == (w & 1)) {
            f32x4 acc = (f32x4){0.f, 0.f, 0.f, 0.f};
            if (st <= jt) {
#pragma unroll
                for (int ks = 0; ks < 4; ++ks) acc = __builtin_amdgcn_mfma_f32_16x16x32_bf16(kf[ks], qf[jt][ks], acc, 0, 0, 0);
            }
            const int j = 16 * jt + n; const float mxj = GMX[(t0 + j) * 4 + h];
            float v[4], rs = 0.f;
#pragma unroll
            for (int i = 0; i < 4; ++i) { const int s = 16 * st + 4 * g + i; const float a = GA[(t0 + s) * 4 + h]; v[i] = (s <= j) ? acc[i] * qs * __expf(a - mxj) : 0.f; rs += v[i]; }
            rs += __shfl_xor(rs, 16); rs += __shfl_xor(rs, 32);
            if (g == 0) denp[st * 64 + j] = rs;
            v2u pk; pk.x = cvt_pk_bf16(v[0], v[1]); pk.y = cvt_pk_bf16(v[2], v[3]);
            *(LAS v2u*)(scT + j * 72 + 16 * st + 4 * g) = pk;
        }
        __syncthreads();
        { const int j = F.tid >> 3, dc = F.tid & 7; const bf16* qp = ZB + (size_t)(t0 + j) * 3072 + h * 128 + dc * 16; const v4u q0 = *(const v4u*)qp, q1 = *(const v4u*)(qp + 8);
          const unsigned qq[8] = {q0.x, q0.y, q0.z, q0.w, q1.x, q1.y, q1.z, q1.w}; float p = 0.f;
#pragma unroll
          for (int i = 0; i < 8; ++i) p += bf_lo(qq[i]) * nin[dc * 16 + 2 * i] + bf_hi(qq[i]) * nin[dc * 16 + 2 * i + 1];
          p += __shfl_xor(p, 1); p += __shfl_xor(p, 2); p += __shfl_xor(p, 4);
          if (dc == 0) qn[j] = p * qs; }
        f32x4 acc[2][4];
#pragma unroll
        for (int mt = 0; mt < 2; ++mt)
#pragma unroll
            for (int jt = 0; jt < 4; ++jt) acc[mt][jt] = (f32x4){0.f, 0.f, 0.f, 0.f};
#pragma unroll
        for (int ks = 0; ks < 4; ++ks)
#pragma unroll
            for (int mt = 0; mt < 2; ++mt)
#pragma unroll
                for (int jt = 0; jt < 4; ++jt) acc[mt][jt] = __builtin_amdgcn_mfma_f32_16x16x32_bf16(cf[mt][ks], qf[jt][ks], acc[mt][jt], 0, 0, 0);
        __syncthreads();
        float winter[4], dn[4];
#pragma unroll
        for (int jt = 0; jt < 4; ++jt) { const int j = 16 * jt + n; const float mxj = GMX[(t0 + j) * 4 + h], bj = GB[(t0 + j) * 4 + h];
            winter[jt] = __expf(m_in - mxj); const float dd = winter[jt] * qn[j] + (((denp[j] + denp[64 + j]) + denp[128 + j]) + denp[192 + j]); dn[jt] = fmaxf(fabsf(dd), __expf(-(bj + mxj)));
#pragma unroll
            for (int mt = 0; mt < 2; ++mt) acc[mt][jt] = acc[mt][jt] * (winter[jt] * qs); }
        {
            unsigned ad[8]; v2u rr[8];
#pragma unroll
            for (int ks = 0; ks < 2; ++ks)
#pragma unroll
                for (int mt = 0; mt < 2; ++mt) { const unsigned et = 2u * w + mt; const unsigned ib = vbase + (ks * 2u + (et >> 3)) * 8192u;
                    ad[(ks * 2 + mt) * 2] = ib + tr_addr16((unsigned)F.lane, et & 7u, 0u); ad[(ks * 2 + mt) * 2 + 1] = ib + tr_addr16((unsigned)F.lane, et & 7u, 1u); }
            tr_read8(ad, rr);
#pragma unroll
            for (int ks = 0; ks < 2; ++ks) {
                bf16x8 Bf[4];
#pragma unroll
                for (int jt = 0; jt < 4; ++jt) Bf[jt] = *(const LAS bf16x8*)(scT + (16 * jt + n) * 72 + 32 * ks + 8 * g);
#pragma unroll
                for (int mt = 0; mt < 2; ++mt) { v4u av; av.x = rr[(ks * 2 + mt) * 2].x; av.y = rr[(ks * 2 + mt) * 2].y; av.z = rr[(ks * 2 + mt) * 2 + 1].x; av.w = rr[(ks * 2 + mt) * 2 + 1].y;
#pragma unroll
                    for (int jt = 0; jt < 4; ++jt) acc[mt][jt] = __builtin_amdgcn_mfma_f32_16x16x32_bf16(__builtin_bit_cast(bf16x8, av), Bf[jt], acc[mt][jt], 0, 0, 0); }
            }
        }
#pragma unroll
        for (int jt = 0; jt < 4; ++jt) { const float inv = 1.0f / dn[jt]; float q = 0.f;
#pragma unroll
            for (int mt = 0; mt < 2; ++mt) { acc[mt][jt] = acc[mt][jt] * inv; const f32x4 a = acc[mt][jt]; q += (a.x * a.x + a.y * a.y) + (a.z * a.z + a.w * a.w); }
            q += __shfl_xor(q, 16); q += __shfl_xor(q, 32);
            if (g == 0) ssp[w * 64 + 16 * jt + n] = q; }
        __syncthreads();
#pragma unroll
        for (int jt = 0; jt < 4; ++jt) { const int j = 16 * jt + n; float sq = 0.f;
#pragma unroll
            for (int w8 = 0; w8 < 8; ++w8) sq += ssp[w8 * 64 + j];
            const float rstd = 1.0f / sqrtf(sq * (1.f / 256.f) + EPS);
#pragma unroll
            for (int mt = 0; mt < 2; ++mt) { const int e = 32 * w + 16 * mt + 4 * g; const f32x4 gv = *(const f32x4*)(gn + h * 256 + e);
                const v2u mo = *(const v2u*)(ZB + (size_t)(t0 + j) * 3072 + 2048 + h * 256 + e);
                const float o0 = bf_lo(mo.x), o1 = bf_hi(mo.x), o2 = bf_lo(mo.y), o3 = bf_hi(mo.y);
                const f32x4 a = acc[mt][jt] * rstd * gv;
                v2u pk; pk.x = cvt_pk_bf16(a.x / (1.f + __expf(-o0)), a.y / (1.f + __expf(-o1))); pk.y = cvt_pk_bf16(a.z / (1.f + __expf(-o2)), a.w / (1.f + __expf(-o3)));
                *(v2u*)(AO + (size_t)(t0 + j) * 3072 + 2048 + h * 256 + e) = pk; } }
    }
    __syncthreads();
}


#ifndef SEL_COUNT_REP
#define SEL_COUNT_REP 1
#endif
#ifndef DSA_REP_SCORE
#define DSA_REP_SCORE 1
#endif
#ifndef DSA_REP_SEL
#define DSA_REP_SEL 1
#endif
__device__ __forceinline__ void dsa_select_phase(Frame& F, const bf16* __restrict__ QIDX, const bf16* __restrict__ KIDX, const float* __restrict__ ZF, unsigned short* IDXL) {
    const int lane = F.lane, w = F.wave;
    LAS float* SC = (LAS float*)(F.lds);
    LAS int* list = (LAS int*)(F.lds + 131072 + w * 1280);
    for (int it = 0; it < 8; ++it) {
        for (int blk = blockIdx.x; blk < 256; blk += F.G) {
        const int b = it >> 1, gi = (it & 1) ? (511 - blk) : blk;
        const int p0 = gi * 8, t0 = b * SEQ + p0, bt0 = b * SEQ;
        __syncthreads();
        for (int rs_ = 0; rs_ < DSA_REP_SCORE; ++rs_) if (p0 + 7 >= 256) {
            int lo_ = lane; asm volatile("" : "+v"(lo_));
            const int hf = lo_ >> 5, n32 = lo_ & 31;
            bf16x8 Aq[2][4]; float wv[2][16];
            const int m = n32, qloc = 2 * (m >> 4) + ((m >> 2) & 1), hd = 4 * ((m >> 3) & 1) + (m & 3);
#pragma unroll
            for (int a = 0; a < 2; ++a)
#pragma unroll
                for (int ks = 0; ks < 4; ++ks) Aq[a][ks] = *(const bf16x8*)(QIDX + (size_t)(t0 + 4 * a + qloc) * 512 + hd * 64 + ks * 16 + hf * 8);
#pragma unroll
            for (int a = 0; a < 2; ++a)
#pragma unroll
                for (int i = 0; i < 16; ++i) wv[a][i] = ZF[(size_t)(t0 + 4 * a + 2 * (i >> 3) + hf) * 1024 + 768 + 64 + (i & 7)];
            const int nkt = (p0 + 7) / 32 + 1;
            const bf16* kb = KIDX + (size_t)(bt0 + n32) * 64 + hf * 8;
            bf16x8 Bk[4], Bn[4];
            if (w < nkt) {
#pragma unroll
                for (int ks = 0; ks < 4; ++ks) Bk[ks] = *(const bf16x8*)(kb + (size_t)(32 * w) * 64 + ks * 16);
            }
            for (int kt = w; kt < nkt; kt += NWAVES) {
                if (kt + NWAVES < nkt) {
#pragma unroll
                    for (int ks = 0; ks < 4; ++ks) Bn[ks] = *(const bf16x8*)(kb + (size_t)(32 * (kt + NWAVES)) * 64 + ks * 16);
                }
#pragma unroll
                for (int a = 0; a < 2; ++a) {
                    f32x16 acc; for (int i = 0; i < 16; ++i) acc[i] = 0.f;
#pragma unroll
                    for (int ks = 0; ks < 4; ++ks) acc = __builtin_amdgcn_mfma_f32_32x32x16_bf16(Aq[a][ks], Bk[ks], acc, 0, 0, 0);
                    float s0 = 0.f, s1 = 0.f;
#pragma unroll
                    for (int i = 0; i < 8; ++i) { s0 += wv[a][i] * fmaxf(acc[i], 0.f); s1 += wv[a][8 + i] * fmaxf(acc[8 + i], 0.f); }
                    SC[(4 * a + hf) * 4096 + 32 * kt + n32] = s0; SC[(4 * a + 2 + hf) * 4096 + 32 * kt + n32] = s1;
                }
#pragma unroll
                for (int ks = 0; ks < 4; ++ks) Bk[ks] = Bn[ks];
            }
        }
        __syncthreads();
        const int p = p0 + w, t = t0 + w;
        for (int rs_ = 0; rs_ < DSA_REP_SEL; ++rs_) if (p < 256) {
#pragma unroll
            for (int i = 0; i < 4; ++i) { const int idx = 64 * i + lane; list[idx] = idx <= p ? idx : 0; }
        } else {
            float v[64];
            const LAS float* srow = SC + w * 4096;
            const int ngr = (p >> 9) + 1;
            const float NEG = -__builtin_inff();
#pragma unroll
            for (int i = 0; i < 64; ++i) { const int s = 64 * i + lane; const float x = srow[s]; v[i] = (s > p) ? NEG : x; }
            float gm[4] = {NEG, NEG, NEG, NEG};
#pragma unroll
            for (int gr = 0; gr < 8; ++gr) if (gr < ngr) {
#pragma unroll
                for (int i = 8 * gr; i < 8 * gr + 8; ++i) gm[i & 3] = fmaxf(gm[i & 3], v[i]); }
            float hi = fmaxf(fmaxf(gm[0], gm[1]), fmaxf(gm[2], gm[3])), lo = fminf(fminf(gm[0], gm[1]), fminf(gm[2], gm[3]));
#pragma unroll
            for (int o = 1; o < 64; o <<= 1) { hi = fmaxf(hi, __shfl_xor(hi, o)); lo = fminf(lo, __shfl_xor(lo, o)); }
#define DSA_COUNT(thr, out) do { unsigned c0_ = 0u, c1_ = 0u, c2_ = 0u, c3_ = 0u; const float th_ = (thr); \
            _Pragma("unroll") for (int gr = 0; gr < 8; ++gr) if (gr < ngr) { \
                c0_ += (__builtin_bit_cast(unsigned, v[8 * gr + 0] - th_) >> 31) ; c1_ += (__builtin_bit_cast(unsigned, v[8 * gr + 1] - th_) >> 31); \
                c2_ += (__builtin_bit_cast(unsigned, v[8 * gr + 2] - th_) >> 31) ; c3_ += (__builtin_bit_cast(unsigned, v[8 * gr + 3] - th_) >> 31); \
                c0_ += (__builtin_bit_cast(unsigned, v[8 * gr + 4] - th_) >> 31) ; c1_ += (__builtin_bit_cast(unsigned, v[8 * gr + 5] - th_) >> 31); \
                c2_ += (__builtin_bit_cast(unsigned, v[8 * gr + 6] - th_) >> 31) ; c3_ += (__builtin_bit_cast(unsigned, v[8 * gr + 7] - th_) >> 31); } \
            int c_ = (int)((c0_ + c1_) + (c2_ + c3_)); \
            c_ += __builtin_amdgcn_update_dpp(0, c_, 0xB1, 0xF, 0xF, true); c_ += __builtin_amdgcn_update_dpp(0, c_, 0x4E, 0xF, 0xF, true); \
            c_ += __builtin_amdgcn_update_dpp(0, c_, 0x141, 0xF, 0xF, true); c_ += __builtin_amdgcn_update_dpp(0, c_, 0x140, 0xF, 0xF, true); \
            out = 512 * ngr - (__builtin_amdgcn_readlane(c_, 0) + __builtin_amdgcn_readlane(c_, 16) + __builtin_amdgcn_readlane(c_, 32) + __builtin_amdgcn_readlane(c_, 48)); } while (0)
            float Tsel = hi; bool exact = false; int c_hi;
            DSA_COUNT(hi, c_hi);
            if (c_hi < 256) {
                for (;;) {
                    const float mid = 0.5f * lo + 0.5f * hi;
                    if (!(mid > lo && mid < hi)) { Tsel = lo; break; }
                    int c; for (int cr_ = 0; cr_ < SEL_COUNT_REP; ++cr_) { DSA_COUNT(mid, c); }
                    if (c == 256) { Tsel = mid; exact = true; break; }
                    if (c > 256) lo = mid; else hi = mid;
                }
            }
#undef DSA_COUNT
            float Ta = Tsel;
            if (exact) { const unsigned tb = __builtin_bit_cast(unsigned, Tsel); const unsigned pb_ = (tb << 1) == 0u ? 0x80000001u : ((tb & 0x80000000u) ? tb + 1u : tb - 1u); Ta = __builtin_bit_cast(float, pb_); }
            int base = 0;
#pragma unroll
            for (int gr = 0; gr < 8; ++gr) if (gr < ngr) {
#pragma unroll
                for (int i = 8 * gr; i < 8 * gr + 8; ++i) { const bool pr = v[i] > Ta; const unsigned long long mk = __ballot(pr); const int pos = base + __builtin_amdgcn_mbcnt_hi((unsigned)(mk >> 32), __builtin_amdgcn_mbcnt_lo((unsigned)mk, 0u));
                    list[pr ? pos : 256 + lane] = 64 * i + lane; base += __popcll(mk); } }
            if (base < 256) {
#pragma unroll
                for (int gr = 0; gr < 8; ++gr) if (gr < ngr) {
#pragma unroll
                    for (int i = 8 * gr; i < 8 * gr + 8; ++i) { const bool pr = v[i] == Tsel; const unsigned long long mk = __ballot(pr); const int pos = base + __builtin_amdgcn_mbcnt_hi((unsigned)(mk >> 32), __builtin_amdgcn_mbcnt_lo((unsigned)mk, 0u));
                        list[(pr && pos < 256) ? pos : 256 + lane] = 64 * i + lane; base += __popcll(mk); } }
            }
        }
        LDS_WAIT(); asm volatile("" ::: "memory");
        { const int i0 = list[4 * lane], i1 = list[4 * lane + 1], i2 = list[4 * lane + 2], i3 = list[4 * lane + 3];
          v2u pk; pk.x = (unsigned)i0 | ((unsigned)i1 << 16); pk.y = (unsigned)i2 | ((unsigned)i3 << 16);
          *((v2u*)(IDXL + (size_t)t * 256) + lane) = pk; }
        }
    }
    __syncthreads();
}

__device__ __forceinline__ void dsa_attn_phase(Frame& F, const unsigned short* __restrict__ IDXL, const bf16* __restrict__ QLAT, const bf16* __restrict__ CKVN, bf16* AO) {
    const int w = F.wave, g = F.lane >> 4, n = F.lane & 15;
    LAS unsigned char* kvimg = F.lds + w * 16384;
    LAS int* list = (LAS int*)(F.lds + 131072 + w * 1024);
    const unsigned kvbase = (unsigned)(size_t)kvimg;
    const int gw = blockIdx.x * NWAVES + w, NGW = F.G * NWAVES;
    for (int t = gw; t < T; t += NGW) {
        const int p = t & (SEQ - 1), bt0 = t - p;
        const int count = p < 256 ? p + 1 : 256;
        { const v2u pk = *((const v2u*)(IDXL + (size_t)t * 256) + F.lane);
          list[4 * F.lane] = (int)(pk.x & 0xffffu); list[4 * F.lane + 1] = (int)(pk.x >> 16); list[4 * F.lane + 2] = (int)(pk.y & 0xffffu); list[4 * F.lane + 3] = (int)(pk.y >> 16); }
        bf16x8 qb[8];
#pragma unroll
        for (int s = 0; s < 8; ++s) { if (n < 8) qb[s] = *(const bf16x8*)(QLAT + (size_t)t * 2048 + n * 256 + 32 * s + 8 * g); else { for (int i = 0; i < 8; ++i) qb[s][i] = 0; } }
        f32x4 O[16];
#pragma unroll
        for (int c = 0; c < 16; ++c) O[c] = (f32x4){0.f, 0.f, 0.f, 0.f};
        float m_run = -1e30f, l_run = 0.f;
        const int nch = (count + 31) >> 5;
        const unsigned rowA0 = 8u * (unsigned)(n >> 2) + (unsigned)(n & 3);
        LDS_WAIT(); asm volatile("" ::: "memory");
        for (int ch = 0; ch < nch; ++ch) {
            {
                const int rsub = g, cpos = n;
#pragma unroll
                for (int rgp = 0; rgp < 8; ++rgp) {
                    const int row = 4 * rgp + rsub; const int idx = list[32 * ch + row];
                    const int chn = cpos ^ ((rsub << 2) | (rgp & 3));
                    const bf16* src = CKVN + (size_t)(bt0 + idx) * 256 + chn * 8;
                    __builtin_amdgcn_global_load_lds((const unsigned*)src, (LAS unsigned*)(kvimg + rgp * 1024), 16, 0, 0);
                    __builtin_amdgcn_global_load_lds((const unsigned*)(src + 128), (LAS unsigned*)(kvimg + 8192 + rgp * 1024), 16, 0, 0);
                }
            }
            asm volatile("s_waitcnt vmcnt(0)" ::: "memory");
            f32x4 st[2];
#pragma unroll
            for (int rb = 0; rb < 2; ++rb) { st[rb] = (f32x4){0.f, 0.f, 0.f, 0.f};
#pragma unroll
                for (int s = 0; s < 8; ++s) { const bf16x8 a = *(const LAS bf16x8*)(kvimg + (s >> 2) * 8192 + off_b(rowA0 + 4u * rb, 4u * (s & 3) + g));
                    st[rb] = __builtin_amdgcn_mfma_f32_16x16x32_bf16(a, qb[s], st[rb], 0, 0, 0); } }
            float pv[8]; float mx = -1e30f;
#pragma unroll
            for (int rb = 0; rb < 2; ++rb)
#pragma unroll
                for (int i = 0; i < 4; ++i) { const int kp = 32 * ch + 8 * g + 4 * rb + i; const float sv = (kp < count) ? st[rb][i] : -1e30f; pv[rb * 4 + i] = sv; mx = fmaxf(mx, sv); }
            mx = fmaxf(mx, __shfl_xor(mx, 16)); mx = fmaxf(mx, __shfl_xor(mx, 32));
            const float m_new = fmaxf(m_run, mx), alpha = exp2f(m_run - m_new); m_run = m_new;
            float ps = 0.f;
#pragma unroll
            for (int i = 0; i < 8; ++i) { pv[i] = exp2f(pv[i] - m_new); ps += pv[i]; }
            l_run = l_run * alpha + ps;
#pragma unroll
            for (int c = 0; c < 16; ++c) O[c] = O[c] * alpha;
            bf16x8 pb; { v4u pk; pk.x = cvt_pk_bf16(pv[0], pv[1]); pk.y = cvt_pk_bf16(pv[2], pv[3]); pk.z = cvt_pk_bf16(pv[4], pv[5]); pk.w = cvt_pk_bf16(pv[6], pv[7]); pb = __builtin_bit_cast(bf16x8, pk); }
            const unsigned q4 = (unsigned)(n >> 2), p4 = (unsigned)(n & 3);
#pragma unroll
            for (int c4 = 0; c4 < 4; ++c4) {
                unsigned ad[8]; v2u rr[8];
#pragma unroll
                for (int cc = 0; cc < 4; ++cc) { const int c = 4 * c4 + cc; const unsigned ib = kvbase + (unsigned)(c >> 3) * 8192u, c7 = (unsigned)(c & 7);
                    ad[2 * cc] = ib + off_b(8u * g + q4, 2u * c7 + (p4 >> 1)) + 8u * (p4 & 1u); ad[2 * cc + 1] = ib + off_b(8u * g + 4u + q4, 2u * c7 + (p4 >> 1)) + 8u * (p4 & 1u); }
                tr_read8(ad, rr);
#pragma unroll
                for (int cc = 0; cc < 4; ++cc) { v4u av; av.x = rr[2 * cc].x; av.y = rr[2 * cc].y; av.z = rr[2 * cc + 1].x; av.w = rr[2 * cc + 1].y;
                    O[4 * c4 + cc] = __builtin_amdgcn_mfma_f32_16x16x32_bf16(__builtin_bit_cast(bf16x8, av), pb, O[4 * c4 + cc], 0, 0, 0); }
            }
        }
        float lt = l_run; lt += __shfl_xor(lt, 16); lt += __shfl_xor(lt, 32);
        const float inv = 1.0f / lt;
        if (n < 8) {
#pragma unroll
            for (int c = 0; c < 16; ++c) { const f32x4 o = O[c] * inv; v2u pk; pk.x = cvt_pk_bf16(o.x, o.y); pk.y = cvt_pk_bf16(o.z, o.w);
                *(v2u*)(AO + (size_t)t * 3072 + n * 256 + 16 * c + 4 * g) = pk; }
        }
    }
}

__device__ __forceinline__ void router_phase(Frame& F, const bf16* __restrict__ H, const bf16* __restrict__ WR, const float* __restrict__ rbias, int* ecnt, int* EIDX, float* GATE, int* RANK) {
    LAS float* lg = (LAS float*)(F.lds) + F.wave * (16 * 33);
    LAS int* hist = (LAS int*)(F.lds + 32768); LAS int* basee = hist + 32;
    const int g = F.lane >> 4, n = F.lane & 15;
    VM_WAIT();
    for (int tb = blockIdx.x; tb < 256; tb += F.G) {
        __syncthreads();
        if (F.tid < 32) hist[F.tid] = 0;
        __syncthreads();
        int e0 = 0, e1 = 0, lr0 = 0, lr1 = 0; float g0 = 0.f, g1 = 0.f; const int r0 = tb * 64 + F.wave * 16;
        if (F.wave < 4) {
            f32x4 acc[2] = {(f32x4){0.f, 0.f, 0.f, 0.f}, (f32x4){0.f, 0.f, 0.f, 0.f}};
            for (int s0 = 0; s0 < 64; s0 += 8) {
                bf16x8 Af[8], Bf[8][2];
#pragma unroll
                for (int u = 0; u < 8; ++u) { Af[u] = *(const bf16x8*)(H + (size_t)(r0 + n) * D + 32 * (s0 + u) + 8 * g);
#pragma unroll
                    for (int nt = 0; nt < 2; ++nt) Bf[u][nt] = *(const bf16x8*)(WR + (size_t)(16 * nt + n) * D + 32 * (s0 + u) + 8 * g); }
#pragma unroll
                for (int u = 0; u < 8; ++u)
#pragma unroll
                    for (int nt = 0; nt < 2; ++nt) acc[nt] = __builtin_amdgcn_mfma_f32_16x16x32_bf16(Af[u], Bf[u][nt], acc[nt], 0, 0, 0);
            }
#pragma unroll
            for (int nt = 0; nt < 2; ++nt)
#pragma unroll
                for (int i = 0; i < 4; ++i) lg[(4 * g + i) * 33 + 16 * nt + n] = acc[nt][i];
            LDS_WAIT(); asm volatile("" ::: "memory");
            if (F.lane < 16) {
                const LAS float* row = lg + F.lane * 33;
                float best = -1e30f; int bg = 0;
                for (int gi = 0; gi < 4; ++gi) { float m1 = -1e30f, m2 = -1e30f;
                    for (int j = 0; j < 8; ++j) { const int e = gi * 8 + j; const float sel = 1.f / (1.f + __expf(-row[e])) + rbias[e]; if (sel > m1) { m2 = m1; m1 = sel; } else if (sel > m2) m2 = sel; }
                    const float gs = m1 + m2; if (gs > best) { best = gs; bg = gi; } }
                float m1 = -1e30f, m2 = -1e30f; int i1 = 0, i2 = 0;
                for (int j = 0; j < 8; ++j) { const int e = bg * 8 + j; const float sel = 1.f / (1.f + __expf(-row[e])) + rbias[e];
                    if (sel > m1) { m2 = m1; i2 = i1; m1 = sel; i1 = j; } else if (sel > m2) { m2 = sel; i2 = j; } }
                e0 = bg * 8 + i1; e1 = bg * 8 + i2;
                const float a0 = 1.f / (1.f + __expf(-row[e0])), a1 = 1.f / (1.f + __expf(-row[e1]));
                g0 = a0 / (a0 + a1); g1 = a1 / (a0 + a1);
                lr0 = __hip_atomic_fetch_add(&hist[e0], 1, __ATOMIC_RELAXED, __HIP_MEMORY_SCOPE_WORKGROUP); lr1 = __hip_atomic_fetch_add(&hist[e1], 1, __ATOMIC_RELAXED, __HIP_MEMORY_SCOPE_WORKGROUP);
            }
        }
        __syncthreads();
        if (F.tid < 32) basee[F.tid] = atomicAdd(&ecnt[F.tid], hist[F.tid]);
        __syncthreads();
        if (F.wave < 4 && F.lane < 16) { const int t = r0 + F.lane;
            EIDX[2 * t] = e0; EIDX[2 * t + 1] = e1; GATE[2 * t] = g0; GATE[2 * t + 1] = g1; RANK[2 * t] = basee[e0] + lr0; RANK[2 * t + 1] = basee[e1] + lr1; }
    }
    __syncthreads();
}
__device__ __forceinline__ void scatter_phase(Frame& F, const bf16* __restrict__ H, const int* __restrict__ ecnt, const int* __restrict__ EIDX, const float* __restrict__ GATE, const int* __restrict__ RANK,
                                              bf16* XS, int* TOKPOS, float* ROWGATE, int* TILEE, int* NT) {
    LAS int* offs = (LAS int*)(F.lds);
    __syncthreads();
    if (F.tid == 0) { int o = 0; for (int e = 0; e < NE; ++e) { offs[e] = o; o += ((ecnt[e] + 255) >> 8) << 8; } offs[NE] = o; }
    __syncthreads();
    if (blockIdx.x == 0) { if (F.tid < NE) { const int t0 = offs[F.tid] >> 8, t1 = offs[F.tid + 1] >> 8; for (int tt = t0; tt < t1; ++tt) TILEE[tt] = F.tid; } if (F.tid == 0) NT[0] = offs[NE] >> 8; }
    const int gw = blockIdx.x * NWAVES + F.wave, NGW = F.G * NWAVES;
    for (int rb = gw; rb < T / 8; rb += NGW) {
        for (int t = rb * 8; t < rb * 8 + 8; ++t) {
            const v4u* src = (const v4u*)(H + (size_t)t * D) + F.lane; v4u v[4];
#pragma unroll
            for (int j = 0; j < 4; ++j) v[j] = src[64 * j];
#pragma unroll
            for (int kk = 0; kk < 2; ++kk) { const int e = EIDX[2 * t + kk], pos = offs[e] + RANK[2 * t + kk];
                v4u* dst = (v4u*)(XS + (size_t)pos * D) + F.lane;
#pragma unroll
                for (int j = 0; j < 4; ++j) dst[64 * j] = v[j];
                if (F.lane == 0) { TOKPOS[2 * t + kk] = pos; ROWGATE[pos] = GATE[2 * t + kk]; } }
        }
    }
}

#ifndef MOE_ALIGN
#define MOE_ALIGN true
#endif
#ifndef MOE_SP2
#define MOE_SP2 true
#endif
constexpr int PH_PER_LAYER = 14, N_PHASES = 1 + 2 * PH_PER_LAYER;
#ifndef PHMASK
#define PHMASK 0xFFFFF
#endif
#ifndef REP_MASK
#define REP_MASK 0
#endif
#define REPS(j) ((((REP_MASK) >> (j)) & 1) ? 2 : 1)
#define EN(j) (ONLY < 0 ? (((PHMASK) >> (j)) & 1) : (ONLY == (j)))
template <int ONLY> __global__ void __launch_bounds__(NTHR, 2) mk_fwd(Args args) {
    extern __shared__ __attribute__((aligned(16))) unsigned char lds_raw[];
    Frame F; F.lds = (LAS unsigned char*)lds_raw; F.tid = threadIdx.x; F.lane = F.tid & 63; const int wave0 = __builtin_amdgcn_readfirstlane(F.tid >> 6); F.wave = wave0; F.G = gridDim.x; F.ws = args.ws; F.ka = nullptr;
    volatile LAS unsigned* MISC = (volatile LAS unsigned*)(F.lds + MISC_OFF);
    if (F.tid < 16) MISC[F.tid] = 0u;
    __syncthreads();
    unsigned* ctl = (unsigned*)(F.ws + WS_CTL);
    const int lo = args.ph_lo, hi = args.ph_hi; const bool multi = (hi - lo) > 1;
    XcdBarrier bar; bar.bar = ctl + CW_BAR; bar.x = 0; bar.st = MISC + 8;
    if (multi) bar = xcd_barrier_post(ctl + CW_BAR, MISC + 8);
#define IN(k) (lo <= (k) && (k) < hi)
#ifndef SEAM_REP
#define SEAM_REP 1
#endif
#define SEAM(k) do { if (IN(k) && IN((k) + 1)) for (int sr_ = 0; sr_ < SEAM_REP; ++sr_) xcd_barrier(bar); } while (0)
#define REFRESH() do { int l_; asm volatile("v_mbcnt_lo_u32_b32 %0, -1, 0\n\tv_mbcnt_hi_u32_b32 %0, -1, %0" : "=v"(l_)); F.lane = l_; F.wave = wave0; F.tid = wave0 * 64 + l_; \
    const char __attribute__((address_space(4)))* k_ = (const char __attribute__((address_space(4)))*)__builtin_amdgcn_kernarg_segment_ptr(); asm volatile("" : "+s"(k_)); F.ka = k_; F.ws = *(unsigned char* const __attribute__((address_space(4)))*)(k_ + 184); } while (0)
#define AOUT (*(float* const __attribute__((address_space(4)))*)(F.ka + 176))
#define WSB (F.ws)
#define MOD ((float*)(WSB + WS_MOD))
#define Hb ((bf16*)(WSB + WS_H))
#define ZF ((float*)(WSB + WS_ZF))
#define ZB ((bf16*)(WSB + WS_ZB))
#define CQN ((bf16*)(WSB + WS_CQN))
#define CKVN ((bf16*)(WSB + WS_CKVN))
#define KIDX ((bf16*)(WSB + WS_KIDX))
#define QLAT ((bf16*)(WSB + WS_QLAT))
#define QIDX ((bf16*)(WSB + WS_QIDX))
#define AO ((bf16*)(WSB + WS_AO))
#define X1 ((float*)(WSB + WS_X1))
#define X2 ((float*)(WSB + WS_X2))
#define GA ((float*)(WSB + WS_GATE + GATE_GA))
#define GMX ((float*)(WSB + WS_GATE + GATE_GMX))
#define GB ((float*)(WSB + WS_GATE + GATE_GB))
#define MINS ((float*)(WSB + WS_GATE + GATE_MINS))
#define CT ((bf16*)(WSB + WS_CT))
#define NS ((float*)(WSB + WS_NS))
#define XS ((bf16*)(WSB + WS_XS))
#define ACT ((bf16*)(WSB + WS_ACT))
#define YS ((bf16*)(WSB + WS_YS))
#define EIDX ((int*)(WSB + WS_RT + RT_EIDX))
#define GATE ((float*)(WSB + WS_RT + RT_GATE))
#define RANK ((int*)(WSB + WS_RT + RT_RANK))
#define TOKPOS ((int*)(WSB + WS_RT + RT_TOKPOS))
#define ROWGATE ((float*)(WSB + WS_RT + RT_ROWGATE))
#define TILEE ((int*)(WSB + WS_RT + RT_TILEE))
#define NTp ((int*)(WSB + WS_RT + RT_NT))
#define IDXL ((unsigned short*)(WSB + WS_IDXL))
#define ECNT(l) ((int*)(WSB + WS_CTL) + CW_ECNT + (l) * 32)

    if (EN(14) && IN(0)) for (int rep = 0; rep < REPS(14); ++rep) { REFRESH(); p0_prologue(F); }
    SEAM(0);
    for (int l = 0; l < 2; ++l) {
        const int pb = 1 + l * PH_PER_LAYER;
#define mod (MOD + (size_t)l * 4 * 12288)
        if (EN(0) && IN(pb + 0)) for (int rep = 0; rep < REPS(0); ++rep) { REFRESH(); if (l == 0) norm_phase(F, AIN(0), AIN(4), mod + 2048, mod, Hb); }
        if (l == 0) SEAM(pb + 0);
        if (EN(1) && IN(pb + 1)) for (int rep = 0; rep < REPS(1); ++rep) { REFRESH(); pg8::Gemm gm{Hb, (const bf16*)(WSB + WS_WIN) + (size_t)l * NZ * D, T, NZ, D}; pg8::StaticOrder S; S.init(T, NZ, F.G, (int)blockIdx.x);
            EpiZ E{ZF, ZB}; pg8::gemm_phase<EpiZ, pg8::StaticOrder, true, true>(F.lds, gm, S, E, F.wave); }
        SEAM(pb + 1);
        if (EN(2) && IN(pb + 2)) for (int rep = 0; rep < REPS(2); ++rep) { REFRESH(); p3_phase(F, ZF, AIN(6) + l * 512, AIN(7) + l * 256, AIN(12) + l * 4, AIN(13) + l * 4, CQN, CKVN, KIDX, GA, GMX, GB, MINS); }
        SEAM(pb + 2);
        if (EN(3) && IN(pb + 3)) for (int rep = 0; rep < REPS(3); ++rep) { REFRESH(); pg8::Gemm gm{CQN, (const bf16*)(WSB + WS_WQ) + (size_t)l * 2560 * 512, T, 2560, 512}; pg8::StaticOrder S; S.init(T, 2560, F.G, (int)blockIdx.x);
            EpiQ E{QLAT, QIDX}; pg8::gemm_phase<EpiQ, pg8::StaticOrder, true, true>(F.lds, gm, S, E, F.wave); }
        SEAM(pb + 3);
        if (EN(4) && IN(pb + 4)) for (int rep = 0; rep < REPS(4); ++rep) { REFRESH(); m1_scan(F, ZB, GA, GMX, MINS, CT, NS); }
        SEAM(pb + 4);
        if (IN(pb + 5)) {
            if (EN(5)) for (int rep = 0; rep < REPS(5); ++rep) { REFRESH(); dsa_select_phase(F, QIDX, KIDX, ZF, IDXL); }
            if (EN(15)) for (int rep = 0; rep < REPS(15); ++rep) { REFRESH(); m3_out(F, ZB, GA, GMX, GB, MINS, CT, NS, AIN(14) + l * 1024, AO); } }
        SEAM(pb + 5);
        if (EN(6) && IN(pb + 6)) for (int rep = 0; rep < REPS(6); ++rep) { REFRESH(); dsa_attn_phase(F, IDXL, QLAT, CKVN, AO); }
        SEAM(pb + 6);
        if (EN(7) && IN(pb + 7)) for (int rep = 0; rep < REPS(7); ++rep) { REFRESH(); pg8::Gemm gm{AO, (const bf16*)(WSB + WS_WOUT) + (size_t)l * 2048 * 3072, T, 2048, 3072}; pg8::StaticOrder S; S.init(T, 2048, F.G, (int)blockIdx.x);
            EpiRes E{(l == 0) ? AIN(0) : (const float*)X2, X1, mod + 2 * 2048}; pg8::gemm_phase<EpiRes, pg8::StaticOrder, true, true>(F.lds, gm, S, E, F.wave); }
        SEAM(pb + 7);
        if (EN(8) && IN(pb + 8)) for (int rep = 0; rep < REPS(8); ++rep) { REFRESH(); norm_phase(F, X1, AIN(16) + l * 2048, mod + 4 * 2048, mod + 3 * 2048, Hb); }
        if (F.G != 256) SEAM(pb + 8);
        if (EN(9) && IN(pb + 9)) { REFRESH(); router_phase(F, Hb, (const bf16*)(WSB + WS_WR), AIN(18), ECNT(l), EIDX, GATE, RANK); }
        SEAM(pb + 9);
        if (EN(10) && IN(pb + 10)) for (int rep = 0; rep < REPS(10); ++rep) { REFRESH(); scatter_phase(F, Hb, ECNT(l), EIDX, GATE, RANK, XS, TOKPOS, ROWGATE, TILEE, NTp); }
        SEAM(pb + 10);
        if (EN(11) && IN(pb + 11)) for (int rep = 0; rep < REPS(11); ++rep) { REFRESH(); pg8::Gemm gm{XS, (const bf16*)(WSB + WS_WGU) + (size_t)l * 32 * 1024 * 2048, MPAD, 32 * 1024, 2048}; MoeOrder<4> S{TILEE, NTp[0], F.G, (int)blockIdx.x};
            EpiGU E{ACT}; pg8::gemm_phase<EpiGU, MoeOrder<4>, MOE_ALIGN, MOE_SP2>(F.lds, gm, S, E, F.wave); }
        SEAM(pb + 11);
        if (EN(12) && IN(pb + 12)) for (int rep = 0; rep < REPS(12); ++rep) { REFRESH(); pg8::Gemm gm{ACT, (const bf16*)(WSB + WS_WD) + (size_t)l * 32 * 2048 * 512, MPAD, 32 * 2048, 512}; MoeOrder<8> S{TILEE, NTp[0], F.G, (int)blockIdx.x};
            EpiDN E{YS, ROWGATE}; pg8::gemm_phase<EpiDN, MoeOrder<8>, MOE_ALIGN, MOE_SP2>(F.lds, gm, S, E, F.wave); }
        SEAM(pb + 12);
        if (EN(13) && IN(pb + 13)) for (int rep = 0; rep < REPS(13); ++rep) { REFRESH(); const float* mod1 = MOD + (size_t)4 * 12288;
            if (l == 0) combine_phase(F, 0, X1, mod + 5 * 2048, YS, TOKPOS, X2, AIN(4) + 2048, mod1 + 2048, mod1, Hb, nullptr);
            else combine_phase(F, 1, X1, mod + 5 * 2048, YS, TOKPOS, nullptr, AIN(21), nullptr, nullptr, nullptr, AOUT); }
        SEAM(pb + 13);
    }
#undef IN
#undef SEAM
}

#ifndef MK_N_LAUNCHES
#define MK_N_LAUNCHES 1
#endif
extern "C" void kernel_launch(void* const* d_in, const int* in_sizes, int n_in, void* d_out, int out_size, void* d_ws, size_t ws_size, hipStream_t stream) {
    static int grid = 0;
    if (grid == 0) {
        if (n_in != 22 || out_size != T * D || ws_size < WS_END) { fprintf(stderr, "kernel_launch: unexpected problem (n_in %d out %d ws %zu)\n", n_in, out_size, ws_size); grid = -1; return; }
        int dev = 0, cus = 0, per_cu = 0;
        if (hipGetDevice(&dev) != hipSuccess || hipDeviceGetAttribute(&cus, hipDeviceAttributeMultiprocessorCount, dev) != hipSuccess) { grid = -1; return; }
        bool ok = true;
#define SETATTR(K) ok = ok && (hipFuncSetAttribute((const void*)mk_fwd<K>, hipFuncAttributeMaxDynamicSharedMemorySize, LDS_BYTES) == hipSuccess)
#if MK_N_LAUNCHES == 1
        SETATTR(-1);
#else
        SETATTR(14); SETATTR(15); SETATTR(0); SETATTR(1); SETATTR(2); SETATTR(3); SETATTR(4); SETATTR(5); SETATTR(6); SETATTR(7); SETATTR(8); SETATTR(9); SETATTR(10); SETATTR(11); SETATTR(12); SETATTR(13);
#endif
#undef SETATTR
        if (!ok) { fprintf(stderr, "kernel_launch: hipFuncSetAttribute failed\n"); grid = -1; return; }
        if (hipOccupancyMaxActiveBlocksPerMultiprocessor(&per_cu, (const void*)mk_fwd<(MK_N_LAUNCHES == 1 ? -1 : 1)>, NTHR, LDS_BYTES) != hipSuccess || per_cu < 1) fprintf(stderr, "kernel_launch: occupancy query says %d\n", per_cu);
        (void)hipGetLastError();
        grid = cus;
    }
    if (grid < 0) return;
    (void)hipMemsetAsync((char*)d_ws + WS_CTL, 0, CTL_ZERO_BYTES, stream);
    Args a{};
    for (int i = 0; i < 22; ++i) a.in[i] = (const float*)d_in[i];
    a.out = (float*)d_out; a.ws = (unsigned char*)d_ws;
#if MK_N_LAUNCHES == 1
    { a.ph_lo = 0; a.ph_hi = N_PHASES; hipLaunchKernelGGL(mk_fwd<-1>, dim3(grid), dim3(NTHR), LDS_BYTES, stream, a); }
#else
    {
        for (int p = 0; p < N_PHASES; ++p) {
            if (p == 1 + PH_PER_LAYER) continue;
            a.ph_lo = p; a.ph_hi = p + 1;
            const int j = (p == 0) ? 14 : (p - 1) % PH_PER_LAYER;
#define LCASE(K) case K: hipLaunchKernelGGL(mk_fwd<K>, dim3(grid), dim3(NTHR), LDS_BYTES, stream, a); break
            if (j == 5) hipLaunchKernelGGL(mk_fwd<15>, dim3(grid), dim3(NTHR), LDS_BYTES, stream, a);
            switch (j) { LCASE(0); LCASE(1); LCASE(2); LCASE(3); LCASE(4); LCASE(5); LCASE(6); LCASE(7); LCASE(8); LCASE(9); LCASE(10); LCASE(11); LCASE(12); LCASE(13); LCASE(14); }
#undef LCASE
        }
    }
#endif
}
```

```cpp
#include <hip/hip_runtime.h>
#include <cstdio>
#include <cstdint>

#define LAS __attribute__((address_space(3)))
#define GAS __attribute__((address_space(1)))
typedef unsigned short bf16;
typedef short bf16x8 __attribute__((ext_vector_type(8)));
typedef float f32x4 __attribute__((ext_vector_type(4)));
typedef float f32x16 __attribute__((ext_vector_type(16)));
typedef unsigned v4u __attribute__((ext_vector_type(4)));
typedef unsigned v2u __attribute__((ext_vector_type(2)));
#define LDS_WAIT() asm volatile("s_waitcnt lgkmcnt(0)" ::: "memory")
#define VM_WAIT() asm volatile("s_waitcnt vmcnt(0)" ::: "memory")

typedef __bf16 bf16x2_t __attribute__((ext_vector_type(2)));
typedef float f32x2_t __attribute__((ext_vector_type(2)));
__device__ __forceinline__ unsigned cvt_pk_bf16(float lo, float hi) { const f32x2_t f = {lo, hi}; const bf16x2_t b = __builtin_convertvector(f, bf16x2_t); return __builtin_bit_cast(unsigned, b); }
__device__ __forceinline__ float bf_lo(unsigned u) { return __builtin_bit_cast(float, u << 16); }
__device__ __forceinline__ float bf_hi(unsigned u) { return __builtin_bit_cast(float, u & 0xffff0000u); }
__device__ __forceinline__ float wave_sum(float v) {
#pragma unroll
    for (int o = 1; o < 64; o <<= 1) v += __shfl_xor(v, o);
    return v;
}

namespace pg8 {
typedef unsigned short bf16_t;
constexpr int BM = 256, BK = 64, HALF = 128, HTB = HALF * BK * 2, STAGE_BYTES = 8 * HTB, NXCD = 8, WGM = 8;
__host__ __device__ __forceinline__ int lds_byte(int r, int c) { const int st = (r >> 4) * 2 + (c >> 5), rr = r & 15, cc = c & 31, ob = rr * 64 + cc * 2; return st * 1024 + (ob ^ (((ob >> 9) & 1) << 5)); }
__host__ __device__ __forceinline__ void stage_rc(int b, int& R, int& C) { const int st = b / 1024, sb = b % 1024, swz = sb ^ (((sb >> 9) & 1) << 5); R = (st >> 1) * 16 + swz / 64; C = (st & 1) * 32 + (swz % 64) / 2; }
__host__ __device__ __forceinline__ int perm32(int rho) { const int n = rho >> 4, i = rho & 15; return 8 * (i >> 2) + 4 * n + (i & 3); }
struct Unit { int pm, pn; };
struct Gemm { const bf16_t* A; const bf16_t* Bt; int M, N, K; };
struct StaticOrder {
    int nM, nN, nwg, G, c;
    __host__ __device__ void init(int M, int N, int G_, int c_) { nM = M / BM; nN = N / BM; nwg = nM * nN; G = G_; c = c_; }
    __host__ __device__ bool next(int i, Unit& u) const {
        const long L = (long)i * G + c; if (L >= nwg) return false;
        int wgid = (int)L; { const int q = nwg / NXCD, r = nwg % NXCD, xcd = wgid % NXCD, off = wgid / NXCD; wgid = (xcd < r ? xcd * (q + 1) : r * (q + 1) + (xcd - r) * q) + off; }
        const int nig = WGM * nN, gid = wgid / nig, fm = gid * WGM, gsz = (nM - fm) < WGM ? (nM - fm) : WGM;
        u.pm = fm + ((wgid % nig) % gsz); u.pn = (wgid % nig) / gsz; return true;
    }
    __device__ __forceinline__ void a_ready(const Unit&) const {}
    __device__ __forceinline__ void done(const Unit&) const {}
};
template <class Epi, class Sched, bool ALIGN_EPI = false, bool SP2 = false>
__device__ __forceinline__ void gemm_phase(LAS unsigned char* lds, const Gemm g, const Sched& S, const Epi& E, const int wave_id) {
    int lane; asm volatile("v_mbcnt_lo_u32_b32 %0, -1, 0\n\tv_mbcnt_hi_u32_b32 %0, -1, %0" : "=v"(lane));
    const int wid = wave_id, tid = wid * 64 + lane;
    const int wr = wid >> 2, wc = wid & 3, fr = lane & 15, fq = lane >> 4;
    const int K = g.K, nt = K / BK;
    unsigned voffA[2], voffB[2];
#pragma unroll
    for (int i = 0; i < 2; ++i) { int R, C; stage_rc(tid * 16 + i * 8192, R, C); const int Rb = Epi::PERM ? ((R & ~31) + perm32(R & 31)) : R;
        voffA[i] = (unsigned)(R * K + C) * 2u; voffB[i] = (unsigned)(Rb * K + C) * 2u; }
    const size_t kstep = (size_t)(BK * 2);
    const size_t hstep = (size_t)HALF * K * 2;
    const size_t tstep = 2 * hstep;
    const unsigned ldsw = (unsigned)wid * 1024u;
    const int aoff = lds_byte(wr * 64 + fr, fq * 8), boff = lds_byte(wc * 32 + fr, fq * 8);
#define PG8_SA(b, h) (((b) * 2 + (h)) * HTB)
#define PG8_SB(b, h) ((4 + (b) * 2 + (h)) * HTB)
#define PG8_STAGE(bufoff, gbase, voff) do { _Pragma("unroll") for (int _i = 0; _i < 2; ++_i) \
        __builtin_amdgcn_global_load_lds((const unsigned*)((const char*)(gbase) + (voff)[_i]), (LAS unsigned*)(lds + (bufoff) + ldsw + _i * 8192), 16, 0, 0); } while (0)
#define PG8_LDA(dst, b, h) do { _Pragma("unroll") for (int m = 0; m < 4; ++m) _Pragma("unroll") for (int k = 0; k < 2; ++k) dst[m][k] = *(const LAS bf16x8*)(lds + PG8_SA(b, h) + aoff + m * 2048 + k * 1024); } while (0)
#define PG8_LDB(dst, b, h) do { _Pragma("unroll") for (int n = 0; n < 2; ++n) _Pragma("unroll") for (int k = 0; k < 2; ++k) dst[n][k] = *(const LAS bf16x8*)(lds + PG8_SB(b, h) + boff + n * 2048 + k * 1024); } while (0)
#define PG8_MMA(ai, bj, At, Bt) do { __builtin_amdgcn_s_setprio(1); _Pragma("unroll") for (int m = 0; m < 4; ++m) _Pragma("unroll") for (int n = 0; n < 2; ++n) _Pragma("unroll") for (int k = 0; k < 2; ++k) \
        acc[ai][bj][m][n] = __builtin_amdgcn_mfma_f32_16x16x32_bf16(Bt[n][k], At[m][k], acc[ai][bj][m][n], 0, 0, 0); __builtin_amdgcn_s_setprio(0); } while (0)
#define PG8_WAIT_V(n) asm volatile("s_waitcnt vmcnt(" #n ")" ::: "memory")
#define PG8_WAIT_L(n) asm volatile("s_waitcnt lgkmcnt(" #n ")" ::: "memory")
#define PG8_BAR __builtin_amdgcn_s_barrier()
#define PG8_SCHED __builtin_amdgcn_sched_barrier(0)
    Unit cur, nxt; int ui = 0;
    if (!S.next(0, cur)) return;
    f32x4 acc[2][2][4][2];
#pragma unroll
    for (int a = 0; a < 2; ++a)
#pragma unroll
        for (int b = 0; b < 2; ++b)
#pragma unroll
            for (int m = 0; m < 4; ++m)
#pragma unroll
                for (int n = 0; n < 2; ++n) acc[a][b][m][n] = (f32x4){0.f, 0.f, 0.f, 0.f};
    bf16x8 At[4][2], B0[2][2], B1[2][2];
    const char* cA = (const char*)g.A + (size_t)cur.pm * tstep; const char* cB = (const char*)g.Bt + (size_t)cur.pn * tstep;
    S.a_ready(cur);
    if constexpr (SP2) {
        PG8_STAGE(PG8_SB(0, 0), cB, voffB); PG8_STAGE(PG8_SB(0, 1), cB + hstep, voffB); PG8_STAGE(PG8_SA(0, 0), cA, voffA); PG8_STAGE(PG8_SA(0, 1), cA + hstep, voffA);
        if (wr == 1) PG8_BAR;
        PG8_WAIT_V(2); PG8_BAR;
        PG8_STAGE(PG8_SB(1, 0), cB + kstep, voffB); PG8_STAGE(PG8_SA(1, 0), cA + kstep, voffA); PG8_STAGE(PG8_SB(1, 1), cB + hstep + kstep, voffB);
        PG8_WAIT_V(6); PG8_BAR;
    } else {
        PG8_STAGE(PG8_SB(0, 0), cB, voffB); PG8_STAGE(PG8_SA(0, 0), cA, voffA); PG8_STAGE(PG8_SB(0, 1), cB + hstep, voffB); PG8_STAGE(PG8_SA(0, 1), cA + hstep, voffA);
        if (wr == 1) PG8_BAR;
        PG8_WAIT_V(4); PG8_BAR;
        PG8_STAGE(PG8_SB(1, 0), cB + kstep, voffB); PG8_STAGE(PG8_SA(1, 0), cA + kstep, voffA); PG8_STAGE(PG8_SB(1, 1), cB + hstep + kstep, voffB);
        PG8_WAIT_V(6); PG8_BAR;
    }
    for (;;) {
        const bool has_next = S.next(ui + 1, nxt);
        const char* nA = has_next ? (const char*)g.A + (size_t)nxt.pm * tstep : cA; const char* nB = has_next ? (const char*)g.Bt + (size_t)nxt.pn * tstep : cB;
        for (int t = 0; t < nt; t += 2) {
            const bool last = (t == nt - 2);
            const char* a1 = cA + (size_t)(t + 1) * kstep;
            const char* a2 = last ? nA : cA + (size_t)(t + 2) * kstep; const char* b2 = last ? nB : cB + (size_t)(t + 2) * kstep;
            const char* a3 = a2 + kstep; const char* b3 = b2 + kstep;
            if (last && has_next) S.a_ready(nxt);
            if constexpr (SP2) {
            PG8_LDB(B0, 0, 0); PG8_LDB(B1, 0, 1); PG8_SCHED; PG8_LDA(At, 0, 0); PG8_STAGE(PG8_SA(1, 1), a1 + hstep, voffA);
            PG8_WAIT_V(8); PG8_WAIT_L(0); PG8_BAR; PG8_MMA(0, 0, At, B0); PG8_MMA(0, 1, At, B1); PG8_BAR; PG8_SCHED;
            PG8_LDA(At, 0, 1); PG8_STAGE(PG8_SB(0, 0), b2, voffB); PG8_STAGE(PG8_SB(0, 1), b2 + hstep, voffB); PG8_STAGE(PG8_SA(0, 0), a2, voffA);
            PG8_WAIT_V(8); PG8_WAIT_L(0); PG8_BAR; PG8_MMA(1, 0, At, B0); PG8_MMA(1, 1, At, B1); PG8_BAR; PG8_SCHED;
            PG8_LDB(B0, 1, 0); PG8_LDB(B1, 1, 1); PG8_SCHED; PG8_LDA(At, 1, 0); PG8_STAGE(PG8_SA(0, 1), a2 + hstep, voffA);
            PG8_WAIT_V(8); PG8_WAIT_L(0); PG8_BAR; PG8_MMA(0, 0, At, B0); PG8_MMA(0, 1, At, B1); PG8_BAR; PG8_SCHED;
            PG8_LDA(At, 1, 1); PG8_STAGE(PG8_SB(1, 0), b3, voffB); PG8_STAGE(PG8_SB(1, 1), b3 + hstep, voffB); PG8_STAGE(PG8_SA(1, 0), a3, voffA);
            PG8_WAIT_V(8); PG8_WAIT_L(0); PG8_BAR; PG8_MMA(1, 0, At, B0); PG8_MMA(1, 1, At, B1); PG8_BAR; PG8_SCHED;
            } else {
            PG8_LDB(B0, 0, 0); PG8_SCHED; PG8_LDA(At, 0, 0); PG8_STAGE(PG8_SA(1, 1), a1 + hstep, voffA);
            PG8_WAIT_L(8); PG8_BAR; PG8_WAIT_L(0); PG8_MMA(0, 0, At, B0); PG8_BAR; PG8_SCHED;
            PG8_LDB(B1, 0, 1); PG8_STAGE(PG8_SB(0, 0), b2, voffB);
            PG8_BAR; PG8_WAIT_L(0); PG8_MMA(0, 1, At, B1); PG8_BAR;
            PG8_LDA(At, 0, 1); PG8_STAGE(PG8_SA(0, 0), a2, voffA);
            PG8_BAR; PG8_WAIT_L(0); PG8_MMA(1, 0, At, B0); PG8_BAR; PG8_SCHED;
            PG8_STAGE(PG8_SB(0, 1), b2 + hstep, voffB);
            PG8_WAIT_V(6); PG8_BAR; PG8_MMA(1, 1, At, B1); PG8_BAR;
            PG8_LDB(B0, 1, 0); PG8_SCHED; PG8_LDA(At, 1, 0); PG8_STAGE(PG8_SA(0, 1), a2 + hstep, voffA);
            PG8_WAIT_L(8); PG8_BAR; PG8_WAIT_L(0); PG8_MMA(0, 0, At, B0); PG8_BAR; PG8_SCHED;
            PG8_LDB(B1, 1, 1); PG8_STAGE(PG8_SB(1, 0), b3, voffB);
            PG8_BAR; PG8_WAIT_L(0); PG8_MMA(0, 1, At, B1); PG8_BAR;
            PG8_LDA(At, 1, 1); PG8_STAGE(PG8_SA(1, 0), a3, voffA);
            PG8_BAR; PG8_WAIT_L(0); PG8_MMA(1, 0, At, B0); PG8_BAR; PG8_SCHED;
            PG8_STAGE(PG8_SB(1, 1), b3 + hstep, voffB);
            PG8_WAIT_V(6); PG8_BAR; PG8_MMA(1, 1, At, B1); PG8_BAR;
            }
        }
        if constexpr (ALIGN_EPI) { if (wr == 0) PG8_BAR; }
        E(acc, cur, wr, wc, fr, fq); S.done(cur);
        if (!has_next) break;
#pragma unroll
        for (int a = 0; a < 2; ++a)
#pragma unroll
            for (int b = 0; b < 2; ++b)
#pragma unroll
                for (int m = 0; m < 4; ++m)
#pragma unroll
                    for (int n = 0; n < 2; ++n) acc[a][b][m][n] = (f32x4){0.f, 0.f, 0.f, 0.f};
        cur = nxt; cA = nA; cB = nB; ++ui;
        if constexpr (ALIGN_EPI) { if (wr == 1) PG8_BAR; }
    }
    PG8_WAIT_V(0);
    if constexpr (!ALIGN_EPI) { if (wr == 0) PG8_BAR; }
    PG8_BAR;
#undef PG8_SA
#undef PG8_SB
#undef PG8_STAGE
#undef PG8_LDA
#undef PG8_LDB
#undef PG8_MMA
#undef PG8_WAIT_V
#undef PG8_WAIT_L
#undef PG8_BAR
#undef PG8_SCHED
}
}

#define XB_TMO      128
#define XB_XCNT(j)  (256  + 64 * (j))
#define XB_XSUB(j)  (1280 + 64 * (j))
#define XB_XGEN(j)  (2304 + 64 * (j))
#define XB_TOP      3328
#define XB_TOPGEN   3392
#define XCD_BAR_WORDS 3456
#define XB_SPIN_CAP (1u << 18)
__device__ __forceinline__ unsigned xb_ld(unsigned* p)              { return __hip_atomic_load(p, __ATOMIC_RELAXED, __HIP_MEMORY_SCOPE_AGENT); }
__device__ __forceinline__ unsigned xb_add(unsigned* p, unsigned v) { return __hip_atomic_fetch_add(p, v, __ATOMIC_RELAXED, __HIP_MEMORY_SCOPE_AGENT); }
__device__ __forceinline__ unsigned xb_xcc_id() { return (unsigned)__builtin_amdgcn_s_getreg((3 << 11) | 20) & 0xFu; }
#define XB_SPIN(cond, bar) do { unsigned _sp = 0; while (cond) { __builtin_amdgcn_s_sleep(1); \
    if ((++_sp & 255u) == 0u) { if (xb_ld(&(bar)[XB_TMO])) break; if (_sp > XB_SPIN_CAP) { atomicAdd(&(bar)[XB_TMO], 1u); break; } } } } while (0)
struct XcdBarrier { unsigned* bar; unsigned x; volatile LAS unsigned* st; };
__device__ __forceinline__ XcdBarrier xcd_barrier_post(unsigned* bar, volatile LAS unsigned* st) {
    XcdBarrier b; b.bar = bar; b.x = xb_xcc_id(); b.st = st;
    if (threadIdx.x == 0) (void)xb_add(&bar[XB_XCNT(b.x)], 1u);
    return b;
}
__device__ __forceinline__ void xcd_barrier_complete(unsigned* bar, unsigned x, unsigned& nloc, unsigned& nx) {
    const unsigned G = gridDim.x * gridDim.y * gridDim.z;
    unsigned sum, cnt, mine, sp = 0u;
    for (;;) {
        sum = 0u; cnt = 0u; mine = 0u;
#pragma unroll
        for (unsigned j = 0; j < 16; ++j) { const unsigned c = xb_ld(&bar[XB_XCNT(j)]); sum += c; cnt += (c > 0u) ? 1u : 0u; mine = (j == x) ? c : mine; }
        if (sum == G) break;
        __builtin_amdgcn_s_sleep(1);
        if ((++sp & 255u) == 0u) { if (xb_ld(&bar[XB_TMO])) break; if (sp > XB_SPIN_CAP) { atomicAdd(&bar[XB_TMO], 1u); break; } }
    }
    nloc = mine > 0u ? mine : 1u; nx = cnt > 0u ? cnt : 1u;
}
__device__ __forceinline__ void xcd_barrier(const XcdBarrier& b) {
    asm volatile("s_waitcnt vmcnt(0)" ::: "memory");
    __syncthreads();
    if (threadIdx.x == 0) {
        unsigned* bar = b.bar;
        __builtin_amdgcn_s_waitcnt(0);
        unsigned nloc = b.st[0], nx = b.st[1];
        if (nloc == 0u) { xcd_barrier_complete(bar, b.x, nloc, nx); b.st[0] = nloc; b.st[1] = nx; }
        const unsigned old = xb_add(&bar[XB_XSUB(b.x)], 1u);
        const unsigned gen = old / nloc;
        if (old + 1u == (gen + 1u) * nloc) {
            __builtin_amdgcn_fence(__ATOMIC_RELEASE, "agent");
            asm volatile("s_waitcnt vmcnt(0)" ::: "memory");
            const unsigned og = xb_add(&bar[XB_TOP], 1u);
            const unsigned tg = og / nx;
            if (og + 1u == (tg + 1u) * nx) xb_add(&bar[XB_TOPGEN], 1u);
            else XB_SPIN(xb_ld(&bar[XB_TOPGEN]) == tg, bar);
            __builtin_amdgcn_fence(__ATOMIC_ACQUIRE, "agent");
            xb_add(&bar[XB_XGEN(b.x)], 1u);
            asm volatile("s_waitcnt vmcnt(0)" ::: "memory");
        } else {
            XB_SPIN(xb_ld(&bar[XB_XGEN(b.x)]) == gen, bar);
            __builtin_amdgcn_fence(__ATOMIC_ACQUIRE, "agent");
            asm volatile("s_waitcnt vmcnt(0)" ::: "memory");
        }
    }
    __syncthreads();
}

constexpr int T = 16384, SEQ = 4096, NB = 4, D = 2048, DIN = 3920, NZ = 4096;
constexpr int NE = 32;
constexpr int MPAD = 40960;
constexpr float EPS = 1e-6f;
constexpr int NWAVES = 8, NTHR = 512;
constexpr size_t MiB = 1u << 20;
constexpr size_t WS_CTL = 0, CTL_ZERO_BYTES = 1 * MiB;
constexpr int CW_BAR = 4096;
constexpr int CW_ECNT = 8192;
constexpr size_t WS_MOD = 512 * 1024;
constexpr size_t WS_WIN = 2 * MiB, WS_WQ = 34 * MiB, WS_WOUT = 40 * MiB, WS_WR = 64 * MiB, WS_WGU = 66 * MiB, WS_WD = 322 * MiB;
constexpr size_t WS_H = 450 * MiB, WS_ZF = 514 * MiB, WS_ZB = 578 * MiB, WS_CQN = 674 * MiB, WS_CKVN = 690 * MiB, WS_KIDX = 698 * MiB;
constexpr size_t WS_QLAT = 700 * MiB, WS_QIDX = 764 * MiB, WS_AO = 780 * MiB, WS_X1 = 876 * MiB, WS_X2 = 1004 * MiB;
constexpr size_t WS_GATE = 1132 * MiB, WS_CT = 1134 * MiB, WS_NS = 1198 * MiB, WS_XS = 1200 * MiB, WS_ACT = 1360 * MiB, WS_YS = 1400 * MiB, WS_RT = 1560 * MiB, WS_IDXL = 1562 * MiB, WS_AO2 = 1572 * MiB, WS_END = 1636 * MiB;
constexpr size_t WS_WUVT = 65 * MiB;
constexpr size_t GATE_GA = 0, GATE_GMX = 262144, GATE_GB = 524288, GATE_MINS = 786432;
constexpr size_t RT_EIDX = 0, RT_GATE = 131072, RT_RANK = 262144, RT_TOKPOS = 393216, RT_ROWGATE = 524288, RT_TILEE = 524288 + 163840, RT_NT = RT_TILEE + 1024;
constexpr int LDS_BYTES = 147456;
constexpr int MISC_OFF = 140 * 1024;

struct Args { const float* in[22]; float* out; unsigned char* ws; int ph_lo, ph_hi; };

struct Frame {
    LAS unsigned char* lds;
    int tid, lane, wave, G;
    unsigned char* ws;
    const char __attribute__((address_space(4)))* ka;
};

__device__ __forceinline__ int rowmap_win(int n) {
    if (n < 768) return n;
    if (n < 832) return 3840 + (n - 768);
    if (n < 840) return 3904 + (n - 832);
    if (n < 3912) return 768 + (n - 840);
    return 3912 + (n - 3912);
}
__device__ __forceinline__ int rowmap_gu(int n) { return n < 512 ? ((n >> 7) * 256 + (n & 127)) : (((n - 512) >> 7) * 256 + 128 + ((n - 512) & 127)); }

template <int RM>
__device__ __forceinline__ void tr_item(const float* __restrict__ W, int ldw, int nmax, int k0, int n0, bf16* WT, int ldt, int kdst0, LAS float* scr, int lane) {
    const int n4 = lane & 15, kq = lane >> 4; const bool okn = (n0 + 4 * n4) < nmax;
#pragma unroll 8
    for (int i = 0; i < 16; ++i) { const int kk = 4 * i + kq; f32x4 v = (f32x4){0.f, 0.f, 0.f, 0.f};
        if (okn) v = __builtin_nontemporal_load((const f32x4*)(W + (size_t)(k0 + kk) * ldw + n0 + 4 * n4));
        LAS float* d = scr + kk * 65 + 4 * n4; d[0] = v.x; d[1] = v.y; d[2] = v.z; d[3] = v.w; }
    LDS_WAIT(); asm volatile("" ::: "memory");
    const int c = lane & 7;
#pragma unroll
    for (int j = 0; j < 8; ++j) { const int n = (lane >> 3) + 8 * j; const LAS float* s = scr + (8 * c) * 65 + n;
        v4u o; o.x = cvt_pk_bf16(s[0 * 65], s[1 * 65]); o.y = cvt_pk_bf16(s[2 * 65], s[3 * 65]); o.z = cvt_pk_bf16(s[4 * 65], s[5 * 65]); o.w = cvt_pk_bf16(s[6 * 65], s[7 * 65]);
        const int ng = n0 + n; const int row = RM == 1 ? rowmap_win(ng) : (RM == 2 ? rowmap_gu(ng) : ng);
        if (RM == 3) { const int kr = k0 + 8 * c;
            if (ng < nmax) *(v4u*)(WT + ((size_t)(((ng >> 4) * (ldt >> 5) + (kr >> 5)) * 64 + ((kr >> 3) & 3) * 16 + (ng & 15))) * 8) = o; }
        else if (ng < nmax) *(v4u*)(WT + (size_t)row * ldt + kdst0 + k0 + 8 * c) = o; }
    LDS_WAIT(); asm volatile("" ::: "memory");
}

template <bool QT>
__device__ __forceinline__ void fold_item(const float* __restrict__ P, int ps, const float* __restrict__ Q, int qs, bf16* dst, int ldd, float scale, LAS float* Ps, LAS float* Qs, int tid) {
    __syncthreads();
#pragma unroll 4
    for (int it = 0; it < 16; ++it) { const int idx = it * 512 + tid; const int r = idx >> 7, d = idx & 127; Ps[r * 129 + d] = P[(size_t)r * ps + d]; }
    if (!QT) {
#pragma unroll 4
        for (int it = 0; it < 16; ++it) { const int idx = it * 512 + tid; const int r = idx >> 7, d = idx & 127; Qs[r * 129 + d] = Q[(size_t)r * qs + d]; }
    } else {
#pragma unroll 4
        for (int it = 0; it < 16; ++it) { const int idx = it * 512 + tid; const int d = idx >> 6, j = idx & 63; Qs[j * 129 + d] = Q[(size_t)d * qs + j]; }
    }
    __syncthreads();
    const int i = tid & 63, j0 = (tid >> 6) * 8;
    float a[8];
#pragma unroll
    for (int jj = 0; jj < 8; ++jj) a[jj] = 0.f;
#pragma unroll 4
    for (int d = 0; d < 128; ++d) { const float p = Ps[i * 129 + d];
#pragma unroll
        for (int jj = 0; jj < 8; ++jj) a[jj] += p * Qs[(j0 + jj) * 129 + d]; }
#pragma unroll
    for (int jj = 0; jj < 8; ++jj) { const unsigned u = cvt_pk_bf16(a[jj] * scale, 0.f); dst[(size_t)(j0 + jj) * ldd + i] = (bf16)(u & 0xffffu); }
}

#define AIN(i) (*(const float* const __attribute__((address_space(4)))*)(F.ka + 8 * (i)))
__device__ __forceinline__ void p0_prologue(Frame& F) {
    const float* c = AIN(1); const float* ada_w = AIN(2); const float* ada_b = AIN(3);
    const float* w_in = AIN(5); const float* w_uq = AIN(8); const float* w_uk = AIN(9); const float* w_uv = AIN(10); const float* w_qidx = AIN(11);
    const float* w_out = AIN(15); const float* router_w = AIN(17); const float* w_gu = AIN(19); const float* w_dn = AIN(20);
    bf16* WIN = (bf16*)(F.ws + WS_WIN); bf16* WQ = (bf16*)(F.ws + WS_WQ); bf16* WOUT = (bf16*)(F.ws + WS_WOUT); bf16* WR = (bf16*)(F.ws + WS_WR);
    bf16* WGU = (bf16*)(F.ws + WS_WGU); bf16* WD = (bf16*)(F.ws + WS_WD); float* MOD = (float*)(F.ws + WS_MOD);
    const int gw = blockIdx.x * NWAVES + F.wave, NGW = F.G * NWAVES;
    __syncthreads();
    {
        LAS float* cs = (LAS float*)(F.lds);
        for (int i = F.tid; i < NB * D; i += NTHR) { const float v = c[i]; cs[i] = v / (1.f + __expf(-v)); }
        __syncthreads();
        constexpr int NCG = 12288 / 128, NTASK = 2 * NCG;
        typedef float f32x2 __attribute__((ext_vector_type(2)));
        LAS float* red = (LAS float*)(F.lds + 32768);
        for (int task = blockIdx.x; task < NTASK; task += F.G) {
            const int cg = task % NCG, l = task / NCG;
            const int n = cg * 128 + F.lane * 2, k0 = F.wave * 256;
            const float* wp = ada_w + ((size_t)l * D + k0) * 12288 + n;
            f32x2 acc[4];
#pragma unroll
            for (int b = 0; b < 4; ++b) acc[b] = (f32x2){0.f, 0.f};
#pragma unroll 8
            for (int k = 0; k < 256; ++k) { const f32x2 w = *(const f32x2*)(wp + (size_t)k * 12288);
#pragma unroll
                for (int b = 0; b < 4; ++b) acc[b] += w * cs[b * D + k0 + k]; }
            __syncthreads();
#pragma unroll
            for (int b = 0; b < 4; ++b) { red[(F.wave * 4 + b) * 128 + F.lane * 2] = acc[b].x; red[(F.wave * 4 + b) * 128 + F.lane * 2 + 1] = acc[b].y; }
            __syncthreads();
            { const int b = F.tid >> 7, c = F.tid & 127; float sum = ada_b[(size_t)l * 12288 + cg * 128 + c];
#pragma unroll
              for (int w8 = 0; w8 < 8; ++w8) sum += red[(w8 * 4 + b) * 128 + c];
              MOD[((size_t)l * 4 + b) * 12288 + cg * 128 + c] = sum; }
        }
        __syncthreads();
    }
    {
        LAS float* Ps = (LAS float*)(F.lds); LAS float* Qs = Ps + 64 * 129;
        constexpr int NQL = 2 * 8 * 8 * 4;
        for (int it = blockIdx.x; it < NQL; it += F.G) {
            const int jt = it & 3, itl = (it >> 2) & 7, h = (it >> 5) & 7, l = it >> 8;
            fold_item<false>(w_uq + (size_t)l * 512 * 1024 + (size_t)(itl * 64) * 1024 + h * 128, 1024, w_uk + (size_t)l * 256 * 1024 + (size_t)(jt * 64) * 1024 + h * 128, 1024,
                             WQ + (size_t)l * 2560 * 512 + (size_t)(h * 256 + jt * 64) * 512 + itl * 64, 512, 0.08838834764831845f * 1.4426950408889634f, Ps, Qs, F.tid);
        }
        __syncthreads();
    }
    {
        LAS float* scr = (LAS float*)(F.lds + F.wave * 16896);
        constexpr int NB_WIN = 62, I_WIN = 32 * NB_WIN, I_QI = 8 * 8, I_WO = 32 * 32, I_UV = 16 * 8, I_R = 32 * 1, I_GU = 32 * 16, I_DN = 8 * 32;
        constexpr int NIT = 2 * I_WIN + 2 * I_QI + 2 * I_WO + I_UV + I_R + 64 * I_GU + 64 * I_DN;
        for (int it = gw; it < NIT; it += NGW) {
            int r = it;
            if (r < 64 * I_GU) { const int le = r / I_GU; r %= I_GU; const int kb = r / 16, nb = r % 16;
                tr_item<2>(w_gu + (size_t)le * 2048 * 1024, 1024, 1024, kb * 64, nb * 64, WGU + (size_t)le * 1024 * 2048, 2048, 0, scr, F.lane); continue; } r -= 64 * I_GU;
            if (r < 64 * I_DN) { const int le = r / I_DN; r %= I_DN; const int kb = r / 32, nb = r % 32;
                tr_item<0>(w_dn + (size_t)le * 512 * 2048, 2048, 2048, kb * 64, nb * 64, WD + (size_t)le * 2048 * 512, 512, 0, scr, F.lane); continue; } r -= 64 * I_DN;
            if (r < 2 * I_WIN) { const int l = r / I_WIN; r %= I_WIN; const int kb = r / NB_WIN, nb = r % NB_WIN;
                tr_item<1>(w_in + (size_t)l * D * DIN, DIN, DIN, kb * 64, nb * 64, WIN + (size_t)l * NZ * D, D, 0, scr, F.lane); continue; } r -= 2 * I_WIN;
            if (r < 2 * I_QI) { const int l = r / I_QI; r %= I_QI; const int kb = r / 8, nb = r % 8;
                tr_item<0>(w_qidx + (size_t)l * 512 * 512, 512, 512, kb * 64, nb * 64, WQ + (size_t)l * 2560 * 512 + (size_t)2048 * 512, 512, 0, scr, F.lane); continue; } r -= 2 * I_QI;
            if (r < 2 * I_WO) { const int l = r / I_WO; r %= I_WO; const int kb = r / 32, nb = r % 32;
                tr_item<0>(w_out + (size_t)l * 2048 * 2048, 2048, 2048, kb * 64, nb * 64, WOUT + (size_t)l * 2048 * 2048, 2048, 0, scr, F.lane); continue; } r -= 2 * I_WO;
            if (r < I_UV) { const int lh = r >> 3, kb = (r >> 1) & 3, nb = r & 1;
                tr_item<3>(w_uv + (size_t)(lh >> 3) * 256 * 1024 + (lh & 7) * 128, 1024, 128, kb * 64, nb * 64, (bf16*)(F.ws + WS_WUVT) + (size_t)lh * 128 * 256, 256, 0, scr, F.lane); continue; } r -= I_UV;
            tr_item<0>(router_w, 32, 32, r * 64, 0, WR, 2048, 0, scr, F.lane);
        }
    }
}

__device__ __forceinline__ void norm_phase(Frame& F, const float* __restrict__ xin, const float* __restrict__ gain, const float* __restrict__ sc, const float* __restrict__ sh, bf16* H) {
    const int gw = blockIdx.x * NWAVES + F.wave, NGW = F.G * NWAVES;
    for (int rb = gw; rb < T / 8; rb += NGW) {
        const int r0 = rb * 8, b = r0 / SEQ;
        f32x4 ga[8], be[8];
#pragma unroll
        for (int j = 0; j < 8; ++j) { const int col = 4 * F.lane + 256 * j; const f32x4 g = *(const f32x4*)(gain + col), s = *(const f32x4*)(sc + (size_t)b * 12288 + col);
            ga[j] = g * (s + 1.0f); be[j] = *(const f32x4*)(sh + (size_t)b * 12288 + col); }
        for (int r = r0; r < r0 + 8; ++r) {
            const f32x4* xr = (const f32x4*)(xin + (size_t)r * D) + F.lane;
            f32x4 v[8]; float s = 0.f;
#pragma unroll
            for (int j = 0; j < 8; ++j) { v[j] = xr[64 * j]; s += (v[j].x * v[j].x + v[j].y * v[j].y) + (v[j].z * v[j].z + v[j].w * v[j].w); }
            const float rstd = 1.0f / sqrtf(wave_sum(s) * (1.f / D) + EPS);
            v2u* o = (v2u*)(H + (size_t)r * D) + F.lane;
#pragma unroll
            for (int j = 0; j < 8; ++j) { const f32x4 y = v[j] * rstd * ga[j] + be[j]; v2u w; w.x = cvt_pk_bf16(y.x, y.y); w.y = cvt_pk_bf16(y.z, y.w); o[64 * j] = w; }
        }
    }
}
__device__ __forceinline__ void combine_phase(Frame& F, int l, const float* __restrict__ X1, const float* __restrict__ g2, const bf16* __restrict__ YS, const int* __restrict__ tokpos,
                                              float* X2, const float* __restrict__ gain, const float* __restrict__ sc, const float* __restrict__ sh, bf16* H, float* out) {
    const int gw = blockIdx.x * NWAVES + F.wave, NGW = F.G * NWAVES;
    for (int rb = gw; rb < T / 8; rb += NGW) {
        const int r0 = rb * 8, b = r0 / SEQ;
        for (int r = r0; r < r0 + 8; ++r) {
            const int p0 = tokpos[2 * r], p1 = tokpos[2 * r + 1];
            const f32x4* xr = (const f32x4*)(X1 + (size_t)r * D) + F.lane;
            const v2u* y0 = (const v2u*)(YS + (size_t)p0 * D) + F.lane; const v2u* y1 = (const v2u*)(YS + (size_t)p1 * D) + F.lane;
            f32x4 v[8]; float s = 0.f;
#pragma unroll
            for (int j = 0; j < 8; ++j) { const int col = 4 * F.lane + 256 * j; const f32x4 g = *(const f32x4*)(g2 + (size_t)b * 12288 + col);
                const v2u a = y0[64 * j], c = y1[64 * j];
                f32x4 ys; ys.x = bf_lo(a.x) + bf_lo(c.x); ys.y = bf_hi(a.x) + bf_hi(c.x); ys.z = bf_lo(a.y) + bf_lo(c.y); ys.w = bf_hi(a.y) + bf_hi(c.y);
                v[j] = xr[64 * j] + g * ys; s += (v[j].x * v[j].x + v[j].y * v[j].y) + (v[j].z * v[j].z + v[j].w * v[j].w); }
            const float rstd = 1.0f / sqrtf(wave_sum(s) * (1.f / D) + EPS);
            if (l == 0) {
                f32x4* xo = (f32x4*)(X2 + (size_t)r * D) + F.lane; v2u* o = (v2u*)(H + (size_t)r * D) + F.lane;
#pragma unroll
                for (int j = 0; j < 8; ++j) { const int col = 4 * F.lane + 256 * j; xo[64 * j] = v[j];
                    const f32x4 g = *(const f32x4*)(gain + col), s1 = *(const f32x4*)(sc + (size_t)b * 12288 + col), h1 = *(const f32x4*)(sh + (size_t)b * 12288 + col);
                    const f32x4 y = v[j] * rstd * g * (s1 + 1.0f) + h1; v2u w; w.x = cvt_pk_bf16(y.x, y.y); w.y = cvt_pk_bf16(y.z, y.w); o[64 * j] = w; }
            } else {
                f32x4* oo = (f32x4*)(out + (size_t)r * D) + F.lane;
#pragma unroll
                for (int j = 0; j < 8; ++j) { const int col = 4 * F.lane + 256 * j; const f32x4 g = *(const f32x4*)(gain + col); oo[64 * j] = v[j] * rstd * g; }
            }
        }
    }
}

struct EpiZ {
    static constexpr bool PERM = true;
    float* ZF; bf16* ZB;
    __device__ __forceinline__ void operator()(const f32x4 (&acc)[2][2][4][2], const pg8::Unit& u, int wr, int wc, int fr, int fq) const {
        const int row0 = u.pm * 256 + wr * 64 + fr, cl = wc * 32 + 8 * fq;
        if (u.pn <= 2 || u.pn == 15) {
            const int cb = (u.pn == 15 ? 768 : u.pn * 256) + cl;
#pragma unroll
            for (int ai = 0; ai < 2; ++ai)
#pragma unroll
                for (int m = 0; m < 4; ++m) { float* rp = ZF + (size_t)(row0 + ai * 128 + m * 16) * 1024 + cb;
#pragma unroll
                    for (int bj = 0; bj < 2; ++bj) { *(f32x4*)(rp + bj * 128) = acc[ai][bj][m][0]; *(f32x4*)(rp + bj * 128 + 4) = acc[ai][bj][m][1]; } }
        } else {
            const int cb = (u.pn - 3) * 256 + cl;
#pragma unroll
            for (int ai = 0; ai < 2; ++ai)
#pragma unroll
                for (int m = 0; m < 4; ++m) { bf16* rp = ZB + (size_t)(row0 + ai * 128 + m * 16) * 3072 + cb;
#pragma unroll
                    for (int bj = 0; bj < 2; ++bj) { const f32x4 v0 = acc[ai][bj][m][0], v1 = acc[ai][bj][m][1]; v4u w;
                        w.x = cvt_pk_bf16(v0[0], v0[1]); w.y = cvt_pk_bf16(v0[2], v0[3]); w.z = cvt_pk_bf16(v1[0], v1[1]); w.w = cvt_pk_bf16(v1[2], v1[3]); *(v4u*)(rp + bj * 128) = w; } }
        }
    }
};
struct EpiQ {
    static constexpr bool PERM = true;
    bf16* QLAT; bf16* QIDX;
    __device__ __forceinline__ void operator()(const f32x4 (&acc)[2][2][4][2], const pg8::Unit& u, int wr, int wc, int fr, int fq) const {
        const int row0 = u.pm * 256 + wr * 64 + fr, cl = wc * 32 + 8 * fq;
        bf16* base; int ld, cb;
        if (u.pn < 8) { base = QLAT; ld = 2048; cb = u.pn * 256 + cl; } else { base = QIDX; ld = 512; cb = (u.pn - 8) * 256 + cl; }
#pragma unroll
        for (int ai = 0; ai < 2; ++ai)
#pragma unroll
            for (int m = 0; m < 4; ++m) { bf16* rp = base + (size_t)(row0 + ai * 128 + m * 16) * ld + cb;
#pragma unroll
                for (int bj = 0; bj < 2; ++bj) { const f32x4 v0 = acc[ai][bj][m][0], v1 = acc[ai][bj][m][1]; v4u w;
                    w.x = cvt_pk_bf16(v0[0], v0[1]); w.y = cvt_pk_bf16(v0[2], v0[3]); w.z = cvt_pk_bf16(v1[0], v1[1]); w.w = cvt_pk_bf16(v1[2], v1[3]); *(v4u*)(rp + bj * 128) = w; } }
    }
};
struct EpiRes {
    static constexpr bool PERM = false;
    const float* Xin; float* X1; const float* g1;
    __device__ __forceinline__ void operator()(const f32x4 (&acc)[2][2][4][2], const pg8::Unit& u, int wr, int wc, int fr, int fq) const {
        const int row0 = u.pm * 256 + wr * 64 + fr, col0 = u.pn * 256 + wc * 32 + 4 * fq; const int b = (u.pm * 256) / SEQ;
        f32x4 gv[2][2];
#pragma unroll
        for (int bj = 0; bj < 2; ++bj)
#pragma unroll
            for (int n = 0; n < 2; ++n) gv[bj][n] = *(const f32x4*)(g1 + (size_t)b * 12288 + col0 + bj * 128 + n * 16);
#pragma unroll
        for (int ai = 0; ai < 2; ++ai)
#pragma unroll
            for (int m = 0; m < 4; ++m) { const size_t off = (size_t)(row0 + ai * 128 + m * 16) * D + col0;
#pragma unroll
                for (int bj = 0; bj < 2; ++bj)
#pragma unroll
                    for (int n = 0; n < 2; ++n) { const f32x4 xi = *(const f32x4*)(Xin + off + bj * 128 + n * 16); *(f32x4*)(X1 + off + bj * 128 + n * 16) = xi + gv[bj][n] * acc[ai][bj][m][n]; } }
    }
};
template <int NPN> struct MoeOrder {
    static constexpr int npn = NPN;
    const int* tile_e; int ntiles, G, c;
    __device__ __forceinline__ bool next(int i, pg8::Unit& u) const {
        if ((G & 7) || ((G >> 3) % npn)) { const int L = i * G + c; if (L >= ntiles * npn) return false; const int tile = L / npn, pn = L % npn; u.pm = tile; u.pn = tile_e[tile] * npn + pn; return true; }
        const int x = c & 7, j = c >> 3, tpx = (G >> 3) / npn; const int tile = i * (8 * tpx) + x * tpx + j / npn, pn = j % npn;
        if (tile >= ntiles) return false; u.pm = tile; u.pn = tile_e[tile] * npn + pn; return true; }
    __device__ __forceinline__ void a_ready(const pg8::Unit&) const {}
    __device__ __forceinline__ void done(const pg8::Unit&) const {}
};
struct EpiGU {
    static constexpr bool PERM = true;
    bf16* ACT;
    __device__ __forceinline__ void operator()(const f32x4 (&acc)[2][2][4][2], const pg8::Unit& u, int wr, int wc, int fr, int fq) const {
        const int row0 = u.pm * 256 + wr * 64 + fr, cb = (u.pn & 3) * 128 + wc * 32 + 8 * fq;
#pragma unroll
        for (int ai = 0; ai < 2; ++ai)
#pragma unroll
            for (int m = 0; m < 4; ++m) { float o[8];
#pragma unroll
                for (int n = 0; n < 2; ++n)
#pragma unroll
                    for (int e = 0; e < 4; ++e) { const float g = acc[ai][0][m][n][e], up = acc[ai][1][m][n][e]; o[n * 4 + e] = g / (1.f + __expf(-g)) * up; }
                v4u w; w.x = cvt_pk_bf16(o[0], o[1]); w.y = cvt_pk_bf16(o[2], o[3]); w.z = cvt_pk_bf16(o[4], o[5]); w.w = cvt_pk_bf16(o[6], o[7]);
                *(v4u*)(ACT + (size_t)(row0 + ai * 128 + m * 16) * 512 + cb) = w; }
    }
};
struct EpiDN {
    static constexpr bool PERM = true;
    bf16* YS; const float* rowgate;
    __device__ __forceinline__ void operator()(const f32x4 (&acc)[2][2][4][2], const pg8::Unit& u, int wr, int wc, int fr, int fq) const {
        const int row0 = u.pm * 256 + wr * 64 + fr, cb = (u.pn & 7) * 256 + wc * 32 + 8 * fq;
#pragma unroll
        for (int ai = 0; ai < 2; ++ai)
#pragma unroll
            for (int m = 0; m < 4; ++m) { const int r = row0 + ai * 128 + m * 16; const float gt = rowgate[r]; bf16* rp = YS + (size_t)r * D + cb;
#pragma unroll
                for (int bj = 0; bj < 2; ++bj) { const f32x4 v0 = acc[ai][bj][m][0] * gt, v1 = acc[ai][bj][m][1] * gt; v4u w;
                    w.x = cvt_pk_bf16(v0[0], v0[1]); w.y = cvt_pk_bf16(v0[2], v0[3]); w.z = cvt_pk_bf16(v1[0], v1[1]); w.w = cvt_pk_bf16(v1[2], v1[3]); *(v4u*)(rp + bj * 128) = w; } }
    }
};

__device__ __forceinline__ float wave_scan_add(float v, int lane) {
#pragma unroll
    for (int o = 1; o < 64; o <<= 1) { const float t = __shfl_up(v, o); if (lane >= o) v += t; }
    return v;
}
__device__ __forceinline__ float wave_scan_max(float v, int lane) {
#pragma unroll
    for (int o = 1; o < 64; o <<= 1) { const float t = __shfl_up(v, o); if (lane >= o) v = fmaxf(v, t); }
    return v;
}
__device__ __forceinline__ void p3_phase(Frame& F, const float* __restrict__ ZF, const float* __restrict__ gq, const float* __restrict__ gkv, const float* __restrict__ ib, const float* __restrict__ fb,
                                         bf16* CQN, bf16* CKVN, bf16* KIDX, float* GA, float* GMX, float* GB, float* MINS) {
    const int gw = blockIdx.x * NWAVES + F.wave, NGW = F.G * NWAVES;
    for (int chain = gw; chain < 16 * NWAVES; chain += NGW) {
        if ((chain & 7) != 0) continue;
        const int ch = chain >> 3, b = ch >> 2, h = ch & 3; const float ibias = ib[h], fbias = fb[h];
        float m_in = 0.f;
        for (int k0 = 0; k0 < 64; k0 += 8) {
            float miv[8], mfv[8];
#pragma unroll
            for (int u = 0; u < 8; ++u) { const int t = b * SEQ + 64 * (k0 + u) + F.lane; miv[u] = ZF[(size_t)t * 1024 + 768 + 72 + h]; mfv[u] = ZF[(size_t)t * 1024 + 768 + 76 + h]; }
#pragma unroll
            for (int u = 0; u < 8; ++u) {
                const int k = k0 + u, t = b * SEQ + 64 * k + F.lane;
                const float mi = miv[u] + ibias, mf = mfv[u] + fbias;
                const float lf = fminf(mf, 0.f) - log1pf(__expf(-fabsf(mf)));
                const float bj = wave_scan_add(lf, F.lane);
                const float a = mi - bj;
                const float mx = fmaxf(m_in, wave_scan_max(a, F.lane));
                GA[t * 4 + h] = a; GMX[t * 4 + h] = mx; GB[t * 4 + h] = bj;
                if (F.lane == 0) MINS[ch * 65 + k] = m_in;
                m_in = __shfl(bj, 63) + __shfl(mx, 63);
            }
        }
        if (F.lane == 0) MINS[ch * 65 + 64] = m_in;
    }
    for (int rb = gw; rb < T / 8; rb += NGW) {
        const f32x4 g0 = *(const f32x4*)(gq + 4 * F.lane), g1 = *(const f32x4*)(gq + 256 + 4 * F.lane), g2 = *(const f32x4*)(gkv + 4 * F.lane);
        for (int r = rb * 8; r < rb * 8 + 8; ++r) {
            const float* zr = ZF + (size_t)r * 1024;
            const f32x4 a0 = *(const f32x4*)(zr + 4 * F.lane), a1 = *(const f32x4*)(zr + 256 + 4 * F.lane), kv = *(const f32x4*)(zr + 512 + 4 * F.lane);
            const float ki = zr[768 + F.lane];
            float s1 = (a0.x * a0.x + a0.y * a0.y) + (a0.z * a0.z + a0.w * a0.w) + (a1.x * a1.x + a1.y * a1.y) + (a1.z * a1.z + a1.w * a1.w);
            float s2 = (kv.x * kv.x + kv.y * kv.y) + (kv.z * kv.z + kv.w * kv.w);
            const float r1 = 1.0f / sqrtf(wave_sum(s1) * (1.f / 512.f) + EPS), r2 = 1.0f / sqrtf(wave_sum(s2) * (1.f / 256.f) + EPS);
            const f32x4 y0 = a0 * r1 * g0, y1 = a1 * r1 * g1, y2 = kv * r2 * g2;
            v2u w; w.x = cvt_pk_bf16(y0.x, y0.y); w.y = cvt_pk_bf16(y0.z, y0.w); *((v2u*)(CQN + (size_t)r * 512) + F.lane) = w;
            w.x = cvt_pk_bf16(y1.x, y1.y); w.y = cvt_pk_bf16(y1.z, y1.w); *((v2u*)(CQN + (size_t)r * 512 + 256) + F.lane) = w;
            w.x = cvt_pk_bf16(y2.x, y2.y); w.y = cvt_pk_bf16(y2.z, y2.w); *((v2u*)(CKVN + (size_t)r * 256) + F.lane) = w;
            KIDX[(size_t)r * 64 + F.lane] = (bf16)(cvt_pk_bf16(ki, 0.f) & 0xffffu);
        }
    }
}

__device__ __forceinline__ unsigned off_b(unsigned row, unsigned ch) { return 256u * row + 16u * (ch ^ (((row & 3u) << 2) | ((row >> 2) & 3u))); }
__device__ __forceinline__ unsigned tr_addr16(unsigned lane, unsigned c, unsigned t) { const unsigned g = lane >> 4, q = (lane & 15u) >> 2, p = lane & 3u; return off_b(8u * g + 4u * t + q, 2u * c + (p >> 1)) + 8u * (p & 1u); }
__device__ __forceinline__ void tr_read8(const unsigned (&a)[8], v2u (&r)[8]) {
    asm volatile("ds_read_b64_tr_b16 %0, %8\n\tds_read_b64_tr_b16 %1, %9\n\tds_read_b64_tr_b16 %2, %10\n\tds_read_b64_tr_b16 %3, %11\n\t"
                 "ds_read_b64_tr_b16 %4, %12\n\tds_read_b64_tr_b16 %5, %13\n\tds_read_b64_tr_b16 %6, %14\n\tds_read_b64_tr_b16 %7, %15\n\ts_waitcnt lgkmcnt(0)"
                 : "=&v"(r[0]), "=&v"(r[1]), "=&v"(r[2]), "=&v"(r[3]), "=&v"(r[4]), "=&v"(r[5]), "=&v"(r[6]), "=&v"(r[7])
                 : "v"(a[0]), "v"(a[1]), "v"(a[2]), "v"(a[3]), "v"(a[4]), "v"(a[5]), "v"(a[6]), "v"(a[7]) : "memory");
}

__device__ __forceinline__ void tr_read4(const unsigned (&a)[4], v2u (&r)[4]) {
    asm volatile("ds_read_b64_tr_b16 %0, %4\n\tds_read_b64_tr_b16 %1, %5\n\tds_read_b64_tr_b16 %2, %6\n\tds_read_b64_tr_b16 %3, %7\n\ts_waitcnt lgkmcnt(0)"
                 : "=&v"(r[0]), "=&v"(r[1]), "=&v"(r[2]), "=&v"(r[3]) : "v"(a[0]), "v"(a[1]), "v"(a[2]), "v"(a[3]) : "memory");
}

#ifndef M1_RC
#define M1_RC 4
#endif
__device__ __forceinline__ void m1_scan(Frame& F, const bf16* __restrict__ ZB, const float* __restrict__ GA, const float* __restrict__ GMX, const float* __restrict__ MINS, bf16* CT, float* NS) {
    LAS unsigned char* kimg = F.lds; LAS bf16* vT = (LAS bf16*)(F.lds + 65536);
    const unsigned kbase = (unsigned)(size_t)kimg;
    const int g = F.lane >> 4, n = F.lane & 15, w = F.wave;
    for (int unit = blockIdx.x; unit < 256; unit += F.G) {
        const int chain = unit >> 4, sl = unit & 15, b = chain >> 2, h = chain & 3; const int bt0 = b * SEQ;
        const int s = F.tid >> 3, dc = F.tid & 7;
        f32x4 C = (f32x4){0.f, 0.f, 0.f, 0.f}, Nacc = (f32x4){0.f, 0.f, 0.f, 0.f};
        bf16x8 ones; for (int i = 0; i < 8; ++i) ones[i] = (short)0x3F80;
        v4u kr[M1_RC][2], vr[M1_RC]; float gav[M1_RC], gmv[M1_RC];
#define M1_PREFETCH(r) do { _Pragma("unroll") for (int c = 0; c < M1_RC; ++c) { const int k_ = M1_RC * (r) + c, t_ = bt0 + 64 * k_ + s; const bf16* kp = ZB + (size_t)t_ * 3072 + 512 + h * 128 + dc * 16; \
            kr[c][0] = *(const v4u*)kp; kr[c][1] = *(const v4u*)(kp + 8); \
            vr[c] = (v4u){0u, 0u, 0u, 0u}; if (F.tid < 128) vr[c] = *(const v4u*)(ZB + (size_t)(bt0 + 64 * k_ + (F.tid >> 1)) * 3072 + 1024 + h * 256 + sl * 16 + (F.tid & 1) * 8); \
            gav[c] = GA[t_ * 4 + h]; gmv[c] = GMX[(bt0 + 64 * k_ + 63) * 4 + h]; } } while (0)
        M1_PREFETCH(0);
        __syncthreads();
        for (int r = 0; r < 64 / M1_RC; ++r) {
            float w_old[M1_RC];
#pragma unroll
            for (int c = 0; c < M1_RC; ++c) {
                LAS bf16* vTb = vT + c * 16 * 72;
                const float wsc = __expf(gav[c] - gmv[c]);
                v4u o0, o1;
                o0.x = cvt_pk_bf16(bf_lo(kr[c][0].x) * wsc, bf_hi(kr[c][0].x) * wsc); o0.y = cvt_pk_bf16(bf_lo(kr[c][0].y) * wsc, bf_hi(kr[c][0].y) * wsc);
                o0.z = cvt_pk_bf16(bf_lo(kr[c][0].z) * wsc, bf_hi(kr[c][0].z) * wsc); o0.w = cvt_pk_bf16(bf_lo(kr[c][0].w) * wsc, bf_hi(kr[c][0].w) * wsc);
                o1.x = cvt_pk_bf16(bf_lo(kr[c][1].x) * wsc, bf_hi(kr[c][1].x) * wsc); o1.y = cvt_pk_bf16(bf_lo(kr[c][1].y) * wsc, bf_hi(kr[c][1].y) * wsc);
                o1.z = cvt_pk_bf16(bf_lo(kr[c][1].z) * wsc, bf_hi(kr[c][1].z) * wsc); o1.w = cvt_pk_bf16(bf_lo(kr[c][1].w) * wsc, bf_hi(kr[c][1].w) * wsc);
                LAS unsigned char* im = kimg + c * 16384 + (s >> 5) * 8192;
                *(LAS v4u*)(im + off_b((unsigned)(s & 31), 2u * dc)) = o0; *(LAS v4u*)(im + off_b((unsigned)(s & 31), 2u * dc + 1u)) = o1;
                if (F.tid < 128) { const unsigned vv[4] = {vr[c].x, vr[c].y, vr[c].z, vr[c].w}; const int vs = F.tid >> 1, e8 = (F.tid & 1) * 8;
#pragma unroll
                    for (int i = 0; i < 4; ++i) { vTb[(e8 + 2 * i) * 72 + vs] = (bf16)(vv[i] & 0xffffu); vTb[(e8 + 2 * i + 1) * 72 + vs] = (bf16)(vv[i] >> 16); } }
                w_old[c] = __expf(MINS[chain * 65 + M1_RC * r + c] - GMX[(bt0 + 64 * (M1_RC * r + c) + 63) * 4 + h]);
            }
            if (r + 1 < 64 / M1_RC) M1_PREFETCH(r + 1);
            __syncthreads();
#pragma unroll
            for (int c = 0; c < M1_RC; ++c) {
                const int k = M1_RC * r + c; LAS bf16* vTb = vT + c * 16 * 72;
                { bf16* cp = CT + ((size_t)(chain * 64 + k) * 256 + sl * 16 + 4 * g) * 128 + 16 * w + n;
#pragma unroll
                  for (int i = 0; i < 4; ++i) cp[(size_t)i * 128] = (bf16)(cvt_pk_bf16(C[i], 0.f) & 0xffffu);
                  if (sl == 0 && g == 0) NS[(size_t)(chain * 64 + k) * 128 + 16 * w + n] = Nacc[0]; }
                C = C * w_old[c]; Nacc = Nacc * w_old[c];
                {
                    const bf16x8 Af0 = *(const LAS bf16x8*)(vTb + n * 72 + 8 * g), Af1 = *(const LAS bf16x8*)(vTb + n * 72 + 32 + 8 * g);
                    unsigned ad[4]; v2u rr[4];
                    const unsigned cb = kbase + (unsigned)c * 16384u;
                    ad[0] = cb + tr_addr16((unsigned)F.lane, (unsigned)w, 0u); ad[1] = cb + tr_addr16((unsigned)F.lane, (unsigned)w, 1u);
                    ad[2] = ad[0] + 8192u; ad[3] = ad[1] + 8192u;
                    tr_read4(ad, rr);
                    v4u b0, b1; b0.x = rr[0].x; b0.y = rr[0].y; b0.z = rr[1].x; b0.w = rr[1].y; b1.x = rr[2].x; b1.y = rr[2].y; b1.z = rr[3].x; b1.w = rr[3].y;
                    const bf16x8 Bf0 = __builtin_bit_cast(bf16x8, b0), Bf1 = __builtin_bit_cast(bf16x8, b1);
                    C = __builtin_amdgcn_mfma_f32_16x16x32_bf16(Af0, Bf0, C, 0, 0, 0);
                    Nacc = __builtin_amdgcn_mfma_f32_16x16x32_bf16(ones, Bf0, Nacc, 0, 0, 0);
                    C = __builtin_amdgcn_mfma_f32_16x16x32_bf16(Af1, Bf1, C, 0, 0, 0);
                    Nacc = __builtin_amdgcn_mfma_f32_16x16x32_bf16(ones, Bf1, Nacc, 0, 0, 0);
                }
            }
            __syncthreads();
        }
#undef M1_PREFETCH
    }
}

__device__ __forceinline__ void m3_out(Frame& F, const bf16* __restrict__ ZB, const float* __restrict__ GA, const float* __restrict__ GMX, const float* __restrict__ GB, const float* __restrict__ MINS,
                                       const bf16* __restrict__ CT, const float* __restrict__ NS, const float* __restrict__ gn, bf16* AO) {
    LAS unsigned char* vimg = F.lds; LAS bf16* scT = (LAS bf16*)(F.lds + 32768);
    LAS float* qn = (LAS float*)(F.lds + 41984); LAS float* nin = (LAS float*)(F.lds + 42240);
    LAS float* denp = (LAS float*)(F.lds + 42752);
    LAS float* ssp = (LAS float*)(F.lds + 43776);
    const unsigned vbase = (unsigned)(size_t)vimg;
    const int g = F.lane >> 4, n = F.lane & 15, w = F.wave;
    const float qs = 0.08838834764831845f;
    for (int unit = blockIdx.x; unit < 1024; unit += F.G) {
        const int chain = unit >> 6, k = unit & 63, b = chain >> 2, h = chain & 3; const int t0 = b * SEQ + 64 * k;
        const int vs = F.tid >> 3, ec = F.tid & 7;
        v4u vr[4];
        { const bf16* vp = ZB + (size_t)(t0 + vs) * 3072 + 1024 + h * 256 + ec * 32;
#pragma unroll
          for (int q = 0; q < 4; ++q) vr[q] = *(const v4u*)(vp + 8 * q); }
        bf16x8 qf[4][4], kf[4], cf[2][4];
        const int st = w >> 1;
#pragma unroll
        for (int ks = 0; ks < 4; ++ks) {
#pragma unroll
            for (int jt = 0; jt < 4; ++jt) qf[jt][ks] = *(const bf16x8*)(ZB + (size_t)(t0 + 16 * jt + n) * 3072 + h * 128 + 32 * ks + 8 * g);
            kf[ks] = *(const bf16x8*)(ZB + (size_t)(t0 + 16 * st + n) * 3072 + 512 + h * 128 + 32 * ks + 8 * g);
#pragma unroll
            for (int mt = 0; mt < 2; ++mt) cf[mt][ks] = *(const bf16x8*)(CT + ((size_t)(chain * 64 + k) * 256 + 32 * w + 16 * mt + n) * 128 + 32 * ks + 8 * g);
        }
        const float nval = (F.tid < 128) ? NS[(size_t)(chain * 64 + k) * 128 + F.tid] : 0.f;
        const float m_in = MINS[chain * 65 + k];
        __syncthreads();
        {
#pragma unroll
            for (int q = 0; q < 4; ++q) *(LAS v4u*)(vimg + ((vs >> 5) * 2 + (ec >> 2)) * 8192 + off_b((unsigned)(vs & 31), 4u * (ec & 3) + q)) = vr[q];
            if (F.tid < 128) nin[F.tid] = nval;
        }
#pragma unroll
        for (int jt = 0; jt < 4; ++jt) if ((jt >> 1) == (w & 1)) {
            f32x4 acc = (f32x4){0.f, 0.f, 0.f, 0.f};
            if (st <= jt) {
#pragma unroll
                for (int ks = 0; ks < 4; ++ks) acc = __builtin_amdgcn_mfma_f32_16x16x32_bf16(kf[ks], qf[jt][ks], acc, 0, 0, 0);
            }
            const int j = 16 * jt + n; const float mxj = GMX[(t0 + j) * 4 + h];
            float v[4], rs = 0.f;
#pragma unroll
            for (int i = 0; i < 4; ++i) { const int s = 16 * st + 4 * g + i; const float a = GA[(t0 + s) * 4 + h]; v[i] = (s <= j) ? acc[i] * qs * __expf(a - mxj) : 0.f; rs += v[i]; }
            rs += __shfl_xor(rs, 16); rs += __shfl_xor(rs, 32);
            if (g == 0) denp[st * 64 + j] = rs;
            v2u pk; pk.x = cvt_pk_bf16(v[0], v[1]); pk.y = cvt_pk_bf16(v[2], v[3]);
            *(LAS v2u*)(scT + j * 72 + 16 * st + 4 * g) = pk;
        }
        __syncthreads();
        { const int j = F.tid >> 3, dc = F.tid & 7; const bf16* qp = ZB + (size_t)(t0 + j) * 3072 + h * 128 + dc * 16; const v4u q0 = *(const v4u*)qp, q1 = *(const v4u*)(qp + 8);
          const unsigned qq[8] = {q0.x, q0.y, q0.z, q0.w, q1.x, q1.y, q1.z, q1.w}; float p = 0.f;
#pragma unroll
          for (int i = 0; i < 8; ++i) p += bf_lo(qq[i]) * nin[dc * 16 + 2 * i] + bf_hi(qq[i]) * nin[dc * 16 + 2 * i + 1];
          p += __shfl_xor(p, 1); p += __shfl_xor(p, 2); p += __shfl_xor(p, 4);
          if (dc == 0) qn[j] = p * qs; }
        f32x4 acc[2][4];
#pragma unroll
        for (int mt = 0; mt < 2; ++mt)
#pragma unroll
            for (int jt = 0; jt < 4; ++jt) acc[mt][jt] = (f32x4){0.f, 0.f, 0.f, 0.f};
#pragma unroll
        for (int ks = 0; ks < 4; ++ks)
#pragma unroll
            for (int mt = 0; mt < 2; ++mt)
#pragma unroll
                for (int jt = 0; jt < 4; ++jt) acc[mt][jt] = __builtin_amdgcn_mfma_f32_16x16x32_bf16(cf[mt][ks], qf[jt][ks], acc[mt][jt], 0, 0, 0);
        __syncthreads();
        float winter[4], dn[4];
#pragma unroll
        for (int jt = 0; jt < 4; ++jt) { const int j = 16 * jt + n; const float mxj = GMX[(t0 + j) * 4 + h], bj = GB[(t0 + j) * 4 + h];
            winter[jt] = __expf(m_in - mxj); const float dd = winter[jt] * qn[j] + (((denp[j] + denp[64 + j]) + denp[128 + j]) + denp[192 + j]); dn[jt] = fmaxf(fabsf(dd), __expf(-(bj + mxj)));
#pragma unroll
            for (int mt = 0; mt < 2; ++mt) acc[mt][jt] = acc[mt][jt] * (winter[jt] * qs); }
        {
            unsigned ad[8]; v2u rr[8];
#pragma unroll
            for (int ks = 0; ks < 2; ++ks)
#pragma unroll
                for (int mt = 0; mt < 2; ++mt) { const unsigned et = 2u * w + mt; const unsigned ib = vbase + (ks * 2u + (et >> 3)) * 8192u;
                    ad[(ks * 2 + mt) * 2] = ib + tr_addr16((unsigned)F.lane, et & 7u, 0u); ad[(ks * 2 + mt) * 2 + 1] = ib + tr_addr16((unsigned)F.lane, et & 7u, 1u); }
            tr_read8(ad, rr);
#pragma unroll
            for (int ks = 0; ks < 2; ++ks) {
                bf16x8 Bf[4];
#pragma unroll
                for (int jt = 0; jt < 4; ++jt) Bf[jt] = *(const LAS bf16x8*)(scT + (16 * jt + n) * 72 + 32 * ks + 8 * g);
#pragma unroll
                for (int mt = 0; mt < 2; ++mt) { v4u av; av.x = rr[(ks * 2 + mt) * 2].x; av.y = rr[(ks * 2 + mt) * 2].y; av.z = rr[(ks * 2 + mt) * 2 + 1].x; av.w = rr[(ks * 2 + mt) * 2 + 1].y;
#pragma unroll
                    for (int jt = 0; jt < 4; ++jt) acc[mt][jt] = __builtin_amdgcn_mfma_f32_16x16x32_bf16(__builtin_bit_cast(bf16x8, av), Bf[jt], acc[mt][jt], 0, 0, 0); }
            }
        }
#pragma unroll
        for (int jt = 0; jt < 4; ++jt) { const float inv = 1.0f / dn[jt]; float q = 0.f;
#pragma unroll
            for (int mt = 0; mt < 2; ++mt) { acc[mt][jt] = acc[mt][jt] * inv; const f32x4 a = acc[mt][jt]; q += (a.x * a.x + a.y * a.y) + (a.z * a.z + a.w * a.w); }
            q += __shfl_xor(q, 16); q += __shfl_xor(q, 32);
            if (g == 0) ssp[w * 64 + 16 * jt + n] = q; }
        __syncthreads();
#pragma unroll
        for (int jt = 0; jt < 4; ++jt) { const int j = 16 * jt + n; float sq = 0.f;
#pragma unroll
            for (int w8 = 0; w8 < 8; ++w8) sq += ssp[w8 * 64 + j];
            const float rstd = 1.0f / sqrtf(sq * (1.f / 256.f) + EPS);
#pragma unroll
            for (int mt = 0; mt < 2; ++mt) { const int e = 32 * w + 16 * mt + 4 * g; const f32x4 gv = *(const f32x4*)(gn + h * 256 + e);
                const v2u mo = *(const v2u*)(ZB + (size_t)(t0 + j) * 3072 + 2048 + h * 256 + e);
                const float o0 = bf_lo(mo.x), o1 = bf_hi(mo.x), o2 = bf_lo(mo.y), o3 = bf_hi(mo.y);
                const f32x4 a = acc[mt][jt] * rstd * gv;
                v2u pk; pk.x = cvt_pk_bf16(a.x / (1.f + __expf(-o0)), a.y / (1.f + __expf(-o1))); pk.y = cvt_pk_bf16(a.z / (1.f + __expf(-o2)), a.w / (1.f + __expf(-o3)));
                *(v2u*)(AO + (size_t)(t0 + j) * 2048 + 1024 + h * 256 + e) = pk; } }
    }
    __syncthreads();
}


#ifndef SEL_COUNT_REP
#define SEL_COUNT_REP 1
#endif
#ifndef DSA_REP_SCORE
#define DSA_REP_SCORE 1
#endif
#ifndef DSA_REP_SEL
#define DSA_REP_SEL 1
#endif
__device__ __forceinline__ void dsa_select_phase(Frame& F, const bf16* __restrict__ QIDX, const bf16* __restrict__ KIDX, const float* __restrict__ ZF, unsigned short* IDXL) {
    const int lane = F.lane, w = F.wave;
    LAS float* SC = (LAS float*)(F.lds);
    LAS int* list = (LAS int*)(F.lds + 131072 + w * 1280);
    bf16x8 Aq[2][4]; float wvx = 0.f;
    LAS float* wtab = (LAS float*)(F.lds + 141312 + w * 256);
    int lo_ = lane; asm volatile("" : "+v"(lo_));
    const int hf = lo_ >> 5, n32 = lo_ & 31;
    const int qloc = 2 * (n32 >> 4) + ((n32 >> 2) & 1), hd = 4 * ((n32 >> 3) & 1) + (n32 & 3);
#define DSA_GROUP(gx, b_, p0_) const int b_ = ((gx) >> 8) >> 1; const int p0_ = ((((gx) >> 8) & 1) ? (511 - ((gx) & 255)) : ((gx) & 255)) * 8
#define DSA_LOAD_GROUP(gx) do { DSA_GROUP(gx, bb_, pp_); const int tt_ = bb_ * SEQ + pp_; if (pp_ + 7 >= 256) { \
        _Pragma("unroll") for (int a = 0; a < 2; ++a) _Pragma("unroll") for (int ks = 0; ks < 4; ++ks) Aq[a][ks] = *(const bf16x8*)(QIDX + (size_t)(tt_ + 4 * a + qloc) * 512 + hd * 64 + ks * 16 + hf * 8); \
        wvx = ZF[(size_t)(tt_ + (lo_ >> 3)) * 1024 + 768 + 64 + (lo_ & 7)]; \
        } } while (0)
    if ((int)blockIdx.x < 2048) DSA_LOAD_GROUP((int)blockIdx.x);
    for (int gidx = blockIdx.x; gidx < 2048; gidx += F.G) {
        {
        DSA_GROUP(gidx, b, p0); const int t0 = b * SEQ + p0, bt0 = b * SEQ;
        __syncthreads();
        for (int rs_ = 0; rs_ < DSA_REP_SCORE; ++rs_) if (p0 + 7 >= 256) {
            const int nkt = (p0 + 7) / 32 + 1;
            const bf16* kb = KIDX + (size_t)(bt0 + n32) * 64 + hf * 8;
            float wv[2][16]; bf16x8 Bk[4], Bn[4];
            if (w < nkt) {
#pragma unroll
                for (int ks = 0; ks < 4; ++ks) Bk[ks] = *(const bf16x8*)(kb + (size_t)(32 * w) * 64 + ks * 16);
            }
            wtab[lo_] = wvx; LDS_WAIT(); asm volatile("" ::: "memory");
#pragma unroll
            for (int a = 0; a < 2; ++a)
#pragma unroll
                for (int hh = 0; hh < 2; ++hh) { const LAS f32x4* tp = (const LAS f32x4*)(wtab + (4 * a + 2 * hh + hf) * 8); const f32x4 u0 = tp[0], u1 = tp[1];
                    wv[a][8 * hh + 0] = u0.x; wv[a][8 * hh + 1] = u0.y; wv[a][8 * hh + 2] = u0.z; wv[a][8 * hh + 3] = u0.w; wv[a][8 * hh + 4] = u1.x; wv[a][8 * hh + 5] = u1.y; wv[a][8 * hh + 6] = u1.z; wv[a][8 * hh + 7] = u1.w; }
            for (int kt = w; kt < nkt; kt += NWAVES) {
                if (kt + NWAVES < nkt) {
#pragma unroll
                    for (int ks = 0; ks < 4; ++ks) Bn[ks] = *(const bf16x8*)(kb + (size_t)(32 * (kt + NWAVES)) * 64 + ks * 16);
                }
#pragma unroll
                for (int a = 0; a < 2; ++a) {
                    f32x16 acc; for (int i = 0; i < 16; ++i) acc[i] = 0.f;
#pragma unroll
                    for (int ks = 0; ks < 4; ++ks) acc = __builtin_amdgcn_mfma_f32_32x32x16_bf16(Aq[a][ks], Bk[ks], acc, 0, 0, 0);
                    float s0 = 0.f, s1 = 0.f;
#pragma unroll
                    for (int i = 0; i < 8; ++i) { s0 += wv[a][i] * fmaxf(acc[i], 0.f); s1 += wv[a][8 + i] * fmaxf(acc[8 + i], 0.f); }
                    SC[(4 * a + hf) * 4096 + 32 * kt + n32] = s0; SC[(4 * a + 2 + hf) * 4096 + 32 * kt + n32] = s1;
                }
#pragma unroll
                for (int ks = 0; ks < 4; ++ks) Bk[ks] = Bn[ks];
            }
        }
        if (gidx + F.G < 2048) DSA_LOAD_GROUP(gidx + F.G);
        __syncthreads();
        const int p = p0 + w, t = t0 + w;
        for (int rs_ = 0; rs_ < DSA_REP_SEL; ++rs_) if (p < 256) {
#pragma unroll
            for (int i = 0; i < 4; ++i) { const int idx = 64 * i + lane; list[idx] = idx <= p ? idx : 0; }
        } else {
            float v[64];
            const LAS float* srow = SC + w * 4096;
            const int ngr = (p >> 9) + 1;
            const float NEG = -__builtin_inff();
            { int lz = lane; asm volatile("" : "+v"(lz)); const int prel = p - lz;
#pragma unroll
            for (int i = 0; i < 64; ++i) { const float x = srow[64 * i + lz]; v[i] = (64 * i > prel) ? NEG : x; } }
            float gm[4] = {NEG, NEG, NEG, NEG};
#pragma unroll
            for (int gr = 0; gr < 8; ++gr) if (gr < ngr) {
#pragma unroll
                for (int i = 8 * gr; i < 8 * gr + 8; ++i) gm[i & 3] = fmaxf(gm[i & 3], v[i]); }
            float hi = fmaxf(fmaxf(gm[0], gm[1]), fmaxf(gm[2], gm[3])), lo = fminf(fminf(gm[0], gm[1]), fminf(gm[2], gm[3]));
#pragma unroll
            for (int o = 1; o < 64; o <<= 1) { hi = fmaxf(hi, __shfl_xor(hi, o)); lo = fminf(lo, __shfl_xor(lo, o)); }
#define DSA_COUNT(thr, out) do { unsigned c0_ = 0u, c1_ = 0u, c2_ = 0u, c3_ = 0u; const float th_ = (thr); \
            _Pragma("unroll") for (int gr = 0; gr < 8; ++gr) if (gr < ngr) { \
                c0_ += (__builtin_bit_cast(unsigned, v[8 * gr + 0] - th_) >> 31) ; c1_ += (__builtin_bit_cast(unsigned, v[8 * gr + 1] - th_) >> 31); \
                c2_ += (__builtin_bit_cast(unsigned, v[8 * gr + 2] - th_) >> 31) ; c3_ += (__builtin_bit_cast(unsigned, v[8 * gr + 3] - th_) >> 31); \
                c0_ += (__builtin_bit_cast(unsigned, v[8 * gr + 4] - th_) >> 31) ; c1_ += (__builtin_bit_cast(unsigned, v[8 * gr + 5] - th_) >> 31); \
                c2_ += (__builtin_bit_cast(unsigned, v[8 * gr + 6] - th_) >> 31) ; c3_ += (__builtin_bit_cast(unsigned, v[8 * gr + 7] - th_) >> 31); } \
            int c_ = (int)((c0_ + c1_) + (c2_ + c3_)); \
            c_ += __builtin_amdgcn_update_dpp(0, c_, 0xB1, 0xF, 0xF, true); c_ += __builtin_amdgcn_update_dpp(0, c_, 0x4E, 0xF, 0xF, true); \
            c_ += __builtin_amdgcn_update_dpp(0, c_, 0x141, 0xF, 0xF, true); c_ += __builtin_amdgcn_update_dpp(0, c_, 0x140, 0xF, 0xF, true); \
            out = 512 * ngr - (__builtin_amdgcn_readlane(c_, 0) + __builtin_amdgcn_readlane(c_, 16) + __builtin_amdgcn_readlane(c_, 32) + __builtin_amdgcn_readlane(c_, 48)); } while (0)
            float Tsel = hi; bool exact = false; int c_hi;
            DSA_COUNT(hi, c_hi);
            if (c_hi < 256) {
                for (int itc_ = 0;; ++itc_) {
                    if (itc_ >= 12 && ((itc_ - 12) & 7) == 0) {
                        float emin = __builtin_inff(), emax = NEG;
#pragma unroll
                        for (int gr = 0; gr < 8; ++gr) if (gr < ngr) {
#pragma unroll
                            for (int i = 8 * gr; i < 8 * gr + 8; ++i) { const bool in = (v[i] >= lo) && (v[i] < hi); emin = in ? fminf(emin, v[i]) : emin; emax = in ? fmaxf(emax, v[i]) : emax; } }
#pragma unroll
                        for (int o = 1; o < 64; o <<= 1) { emin = fminf(emin, __shfl_xor(emin, o)); emax = fmaxf(emax, __shfl_xor(emax, o)); }
                        if (emin == emax) { Tsel = emin; break; }
                        lo = emin;
                    }
                    const float mid = 0.5f * lo + 0.5f * hi;
                    if (!(mid > lo && mid < hi)) { Tsel = lo; break; }
                    int c; for (int cr_ = 0; cr_ < SEL_COUNT_REP; ++cr_) { DSA_COUNT(mid, c); }
                    if (c == 256) { Tsel = mid; exact = true; break; }
                    if (c > 256) lo = mid; else hi = mid;
                }
            }
#undef DSA_COUNT
            float Ta = Tsel;
            if (exact) { const unsigned tb = __builtin_bit_cast(unsigned, Tsel); const unsigned pb_ = (tb << 1) == 0u ? 0x80000001u : ((tb & 0x80000000u) ? tb + 1u : tb - 1u); Ta = __builtin_bit_cast(float, pb_); }
            int base = 0; int lc = lane; asm volatile("" : "+v"(lc));
#pragma unroll
            for (int gr = 0; gr < 8; ++gr) if (gr < ngr) {
#pragma unroll
                for (int i = 8 * gr; i < 8 * gr + 8; ++i) { const bool pr = v[i] > Ta; const unsigned long long mk = __ballot(pr); const int pos = base + __builtin_amdgcn_mbcnt_hi((unsigned)(mk >> 32), __builtin_amdgcn_mbcnt_lo((unsigned)mk, 0u));
                    list[pr ? pos : 256 + lc] = 64 * i + lc; base += __popcll(mk); } }
            if (base < 256) {
#pragma unroll
                for (int gr = 0; gr < 8; ++gr) if (gr < ngr) {
#pragma unroll
                    for (int i = 8 * gr; i < 8 * gr + 8; ++i) { const bool pr = v[i] == Tsel; const unsigned long long mk = __ballot(pr); const int pos = base + __builtin_amdgcn_mbcnt_hi((unsigned)(mk >> 32), __builtin_amdgcn_mbcnt_lo((unsigned)mk, 0u));
                        list[(pr && pos < 256) ? pos : 256 + lc] = 64 * i + lc; base += __popcll(mk); } }
            }
        }
        LDS_WAIT(); asm volatile("" ::: "memory");
        { const int i0 = list[4 * lane], i1 = list[4 * lane + 1], i2 = list[4 * lane + 2], i3 = list[4 * lane + 3];
          v2u pk; pk.x = (unsigned)i0 | ((unsigned)i1 << 16); pk.y = (unsigned)i2 | ((unsigned)i3 << 16);
          *((v2u*)(IDXL + (size_t)t * 256) + lane) = pk; }
        }
    }
#undef DSA_GROUP
#undef DSA_LOAD_GROUP
    __syncthreads();
}

__device__ __forceinline__ void dsa_attn_phase(Frame& F, const unsigned short* __restrict__ IDXL, const bf16* __restrict__ QLAT, const bf16* __restrict__ CKVN, bf16* AO, const bf16* __restrict__ WUVT, bf16* AO2) {
    const int w = F.wave, g = F.lane >> 4, n = F.lane & 15;
    LAS unsigned char* kvimg = F.lds + w * 16384;
    LAS int* list = (LAS int*)(F.lds + 131072 + w * 1024);
    const unsigned kvbase = (unsigned)(size_t)kvimg;
    const int gw = blockIdx.x * NWAVES + w, NGW = F.G * NWAVES;
    for (int t4 = gw; t4 < T; t4 += 4 * NGW) {
    for (int t = t4; t < T && t < t4 + 4 * NGW; t += NGW) {
        const int p = t & (SEQ - 1), bt0 = t - p;
        const int count = p < 256 ? p + 1 : 256;
        { const v2u pk = *((const v2u*)(IDXL + (size_t)t * 256) + F.lane);
          list[4 * F.lane] = (int)(pk.x & 0xffffu); list[4 * F.lane + 1] = (int)(pk.x >> 16); list[4 * F.lane + 2] = (int)(pk.y & 0xffffu); list[4 * F.lane + 3] = (int)(pk.y >> 16); }
        bf16x8 qb[8];
#pragma unroll
        for (int s = 0; s < 8; ++s) { if (n < 8) qb[s] = *(const bf16x8*)(QLAT + (size_t)t * 2048 + n * 256 + 32 * s + 8 * g); else { for (int i = 0; i < 8; ++i) qb[s][i] = 0; } }
        f32x4 O[16];
#pragma unroll
        for (int c = 0; c < 16; ++c) O[c] = (f32x4){0.f, 0.f, 0.f, 0.f};
        float m_run = -1e30f, l_run = 0.f;
        const int nch = (count + 31) >> 5;
        const unsigned rowA0 = 8u * (unsigned)(n >> 2) + (unsigned)(n & 3);
        LDS_WAIT(); asm volatile("" ::: "memory");
        for (int ch = 0; ch < nch; ++ch) {
            {
                const int rsub = g, cpos = n;
#pragma unroll
                for (int rgp = 0; rgp < 8; ++rgp) {
                    const int row = 4 * rgp + rsub; const int idx = list[32 * ch + row];
                    const int chn = cpos ^ ((rsub << 2) | (rgp & 3));
                    const bf16* src = CKVN + (size_t)(bt0 + idx) * 256 + chn * 8;
                    __builtin_amdgcn_global_load_lds((const unsigned*)src, (LAS unsigned*)(kvimg + rgp * 1024), 16, 0, 0);
                    __builtin_amdgcn_global_load_lds((const unsigned*)(src + 128), (LAS unsigned*)(kvimg + 8192 + rgp * 1024), 16, 0, 0);
                }
            }
            asm volatile("s_waitcnt vmcnt(0)" ::: "memory");
            f32x4 st[2];
#pragma unroll
            for (int rb = 0; rb < 2; ++rb) { st[rb] = (f32x4){0.f, 0.f, 0.f, 0.f};
#pragma unroll
                for (int s = 0; s < 8; ++s) { const bf16x8 a = *(const LAS bf16x8*)(kvimg + (s >> 2) * 8192 + off_b(rowA0 + 4u * rb, 4u * (s & 3) + g));
                    st[rb] = __builtin_amdgcn_mfma_f32_16x16x32_bf16(a, qb[s], st[rb], 0, 0, 0); } }
            float pv[8]; float mx = -1e30f;
#pragma unroll
            for (int rb = 0; rb < 2; ++rb)
#pragma unroll
                for (int i = 0; i < 4; ++i) { const int kp = 32 * ch + 8 * g + 4 * rb + i; const float sv = (kp < count) ? st[rb][i] : -1e30f; pv[rb * 4 + i] = sv; mx = fmaxf(mx, sv); }
            mx = fmaxf(mx, __shfl_xor(mx, 16)); mx = fmaxf(mx, __shfl_xor(mx, 32));
            const float m_new = fmaxf(m_run, mx), alpha = exp2f(m_run - m_new); m_run = m_new;
            float ps = 0.f;
#pragma unroll
            for (int i = 0; i < 8; ++i) { pv[i] = exp2f(pv[i] - m_new); ps += pv[i]; }
            l_run = l_run * alpha + ps;
#pragma unroll
            for (int c = 0; c < 16; ++c) O[c] = O[c] * alpha;
            bf16x8 pb; { v4u pk; pk.x = cvt_pk_bf16(pv[0], pv[1]); pk.y = cvt_pk_bf16(pv[2], pv[3]); pk.z = cvt_pk_bf16(pv[4], pv[5]); pk.w = cvt_pk_bf16(pv[6], pv[7]); pb = __builtin_bit_cast(bf16x8, pk); }
            const unsigned q4 = (unsigned)(n >> 2), p4 = (unsigned)(n & 3);
#pragma unroll
            for (int c4 = 0; c4 < 4; ++c4) {
                unsigned ad[8]; v2u rr[8];
#pragma unroll
                for (int cc = 0; cc < 4; ++cc) { const int c = 4 * c4 + cc; const unsigned ib = kvbase + (unsigned)(c >> 3) * 8192u, c7 = (unsigned)(c & 7);
                    ad[2 * cc] = ib + off_b(8u * g + q4, 2u * c7 + (p4 >> 1)) + 8u * (p4 & 1u); ad[2 * cc + 1] = ib + off_b(8u * g + 4u + q4, 2u * c7 + (p4 >> 1)) + 8u * (p4 & 1u); }
                tr_read8(ad, rr);
#pragma unroll
                for (int cc = 0; cc < 4; ++cc) { v4u av; av.x = rr[2 * cc].x; av.y = rr[2 * cc].y; av.z = rr[2 * cc + 1].x; av.w = rr[2 * cc + 1].y;
                    O[4 * c4 + cc] = __builtin_amdgcn_mfma_f32_16x16x32_bf16(__builtin_bit_cast(bf16x8, av), pb, O[4 * c4 + cc], 0, 0, 0); }
            }
        }
        float lt = l_run; lt += __shfl_xor(lt, 16); lt += __shfl_xor(lt, 32);
        const float inv = 1.0f / lt;
        if (n < 8) {
#pragma unroll
            for (int c = 0; c < 16; ++c) { const f32x4 o = O[c] * inv; v2u pk; pk.x = cvt_pk_bf16(o.x, o.y); pk.y = cvt_pk_bf16(o.z, o.w);
                *(v2u*)(AO + (size_t)t * 3072 + n * 256 + 16 * c + 4 * g) = pk; }
        }
    }
    VM_WAIT(); __syncthreads();
    {
        int lq_ = F.lane; asm volatile("" : "+v"(lq_));
        const int g = lq_ >> 4, n = lq_ & 15;
        const int h = w, blk0 = blockIdx.x * NWAVES;
        f32x4 acc[8][2];
#pragma unroll
        for (int nt = 0; nt < 8; ++nt) { acc[nt][0] = (f32x4){0.f, 0.f, 0.f, 0.f}; acc[nt][1] = (f32x4){0.f, 0.f, 0.f, 0.f}; }
        int tq[2];
#pragma unroll
        for (int mt = 0; mt < 2; ++mt) { const int m = 16 * mt + n; int tt = t4 + (m >> 2) - w + (m & 3) * NGW; if (tt >= T) tt = t4; tq[mt] = tt; (void)blk0; }
        const bf16* wb = WUVT + (size_t)h * 128 * 256 + (size_t)lq_ * 8;
        bf16x8 Ao[2][2], Bw[2][8];
#pragma unroll
        for (int mt = 0; mt < 2; ++mt) Ao[0][mt] = *(const bf16x8*)(AO + (size_t)tq[mt] * 3072 + h * 256 + 8 * g);
#pragma unroll
        for (int nt = 0; nt < 8; ++nt) Bw[0][nt] = *(const bf16x8*)(wb + (size_t)(nt * 8) * 512);
#pragma unroll
        for (int ks = 0; ks < 8; ++ks) {
            const int cur = ks & 1, nx = cur ^ 1;
            if (ks + 1 < 8) {
#pragma unroll
                for (int mt = 0; mt < 2; ++mt) Ao[nx][mt] = *(const bf16x8*)(AO + (size_t)tq[mt] * 3072 + h * 256 + 32 * (ks + 1) + 8 * g);
#pragma unroll
                for (int nt = 0; nt < 8; ++nt) Bw[nx][nt] = *(const bf16x8*)(wb + (size_t)(nt * 8 + ks + 1) * 512);
            }
            asm volatile("" ::: "memory");
#pragma unroll
            for (int nt = 0; nt < 8; ++nt)
#pragma unroll
                for (int mt = 0; mt < 2; ++mt) acc[nt][mt] = __builtin_amdgcn_mfma_f32_16x16x32_bf16(Bw[cur][nt], Ao[cur][mt], acc[nt][mt], 0, 0, 0);
        }
#pragma unroll
        for (int mt = 0; mt < 2; ++mt) { const int m = 16 * mt + n; const int tt = t4 + (m >> 2) - w + (m & 3) * NGW;
            if (tt < T) {
#pragma unroll
                for (int nt = 0; nt < 8; ++nt) { const f32x4 a = acc[nt][mt]; v2u pk; pk.x = cvt_pk_bf16(a.x, a.y); pk.y = cvt_pk_bf16(a.z, a.w);
                    *(v2u*)(AO2 + (size_t)tt * 2048 + h * 128 + 16 * nt + 4 * g) = pk; } } }
    }
    }
}

__device__ __forceinline__ void router_phase(Frame& F, const bf16* __restrict__ H, const bf16* __restrict__ WR, const float* __restrict__ rbias, int* ecnt, int* EIDX, float* GATE, int* RANK) {
    LAS float* lg = (LAS float*)(F.lds) + F.wave * (16 * 33);
    LAS int* hist = (LAS int*)(F.lds + 32768); LAS int* basee = hist + 32;
    const int g = F.lane >> 4, n = F.lane & 15;
    VM_WAIT();
    for (int tb = blockIdx.x; tb < 256; tb += F.G) {
        __syncthreads();
        if (F.tid < 32) hist[F.tid] = 0;
        __syncthreads();
        int e0 = 0, e1 = 0, lr0 = 0, lr1 = 0; float g0 = 0.f, g1 = 0.f; const int r0 = tb * 64 + F.wave * 16;
        if (F.wave < 4) {
            f32x4 acc[2] = {(f32x4){0.f, 0.f, 0.f, 0.f}, (f32x4){0.f, 0.f, 0.f, 0.f}};
            for (int s0 = 0; s0 < 64; s0 += 8) {
                bf16x8 Af[8], Bf[8][2];
#pragma unroll
                for (int u = 0; u < 8; ++u) { Af[u] = *(const bf16x8*)(H + (size_t)(r0 + n) * D + 32 * (s0 + u) + 8 * g);
#pragma unroll
                    for (int nt = 0; nt < 2; ++nt) Bf[u][nt] = *(const bf16x8*)(WR + (size_t)(16 * nt + n) * D + 32 * (s0 + u) + 8 * g); }
#pragma unroll
                for (int u = 0; u < 8; ++u)
#pragma unroll
                    for (int nt = 0; nt < 2; ++nt) acc[nt] = __builtin_amdgcn_mfma_f32_16x16x32_bf16(Af[u], Bf[u][nt], acc[nt], 0, 0, 0);
            }
#pragma unroll
            for (int nt = 0; nt < 2; ++nt)
#pragma unroll
                for (int i = 0; i < 4; ++i) lg[(4 * g + i) * 33 + 16 * nt + n] = acc[nt][i];
            LDS_WAIT(); asm volatile("" ::: "memory");
            if (F.lane < 16) {
                const LAS float* row = lg + F.lane * 33;
                float best = -1e30f; int bg = 0;
                for (int gi = 0; gi < 4; ++gi) { float m1 = -1e30f, m2 = -1e30f;
                    for (int j = 0; j < 8; ++j) { const int e = gi * 8 + j; const float sel = 1.f / (1.f + __expf(-row[e])) + rbias[e]; if (sel > m1) { m2 = m1; m1 = sel; } else if (sel > m2) m2 = sel; }
                    const float gs = m1 + m2; if (gs > best) { best = gs; bg = gi; } }
                float m1 = -1e30f, m2 = -1e30f; int i1 = 0, i2 = 0;
                for (int j = 0; j < 8; ++j) { const int e = bg * 8 + j; const float sel = 1.f / (1.f + __expf(-row[e])) + rbias[e];
                    if (sel > m1) { m2 = m1; i2 = i1; m1 = sel; i1 = j; } else if (sel > m2) { m2 = sel; i2 = j; } }
                e0 = bg * 8 + i1; e1 = bg * 8 + i2;
                const float a0 = 1.f / (1.f + __expf(-row[e0])), a1 = 1.f / (1.f + __expf(-row[e1]));
                g0 = a0 / (a0 + a1); g1 = a1 / (a0 + a1);
                lr0 = __hip_atomic_fetch_add(&hist[e0], 1, __ATOMIC_RELAXED, __HIP_MEMORY_SCOPE_WORKGROUP); lr1 = __hip_atomic_fetch_add(&hist[e1], 1, __ATOMIC_RELAXED, __HIP_MEMORY_SCOPE_WORKGROUP);
            }
        }
        __syncthreads();
        if (F.tid < 32) basee[F.tid] = atomicAdd(&ecnt[F.tid], hist[F.tid]);
        __syncthreads();
        if (F.wave < 4 && F.lane < 16) { const int t = r0 + F.lane;
            EIDX[2 * t] = e0; EIDX[2 * t + 1] = e1; GATE[2 * t] = g0; GATE[2 * t + 1] = g1; RANK[2 * t] = basee[e0] + lr0; RANK[2 * t + 1] = basee[e1] + lr1; }
    }
    __syncthreads();
}
__device__ __forceinline__ void scatter_phase(Frame& F, const bf16* __restrict__ H, const int* __restrict__ ecnt, const int* __restrict__ EIDX, const float* __restrict__ GATE, const int* __restrict__ RANK,
                                              bf16* XS, int* TOKPOS, float* ROWGATE, int* TILEE, int* NT) {
    LAS int* offs = (LAS int*)(F.lds);
    __syncthreads();
    if (F.tid == 0) { int o = 0; for (int e = 0; e < NE; ++e) { offs[e] = o; o += ((ecnt[e] + 255) >> 8) << 8; } offs[NE] = o; }
    __syncthreads();
    if (blockIdx.x == 0) { if (F.tid < NE) { const int t0 = offs[F.tid] >> 8, t1 = offs[F.tid + 1] >> 8; for (int tt = t0; tt < t1; ++tt) TILEE[tt] = F.tid; } if (F.tid == 0) NT[0] = offs[NE] >> 8; }
    const int gw = blockIdx.x * NWAVES + F.wave, NGW = F.G * NWAVES;
    for (int rb = gw; rb < T / 8; rb += NGW) {
        for (int t = rb * 8; t < rb * 8 + 8; ++t) {
            const v4u* src = (const v4u*)(H + (size_t)t * D) + F.lane; v4u v[4];
#pragma unroll
            for (int j = 0; j < 4; ++j) v[j] = src[64 * j];
#pragma unroll
            for (int kk = 0; kk < 2; ++kk) { const int e = EIDX[2 * t + kk], pos = offs[e] + RANK[2 * t + kk];
                v4u* dst = (v4u*)(XS + (size_t)pos * D) + F.lane;
#pragma unroll
                for (int j = 0; j < 4; ++j) dst[64 * j] = v[j];
                if (F.lane == 0) { TOKPOS[2 * t + kk] = pos; ROWGATE[pos] = GATE[2 * t + kk]; } }
        }
    }
}

#ifndef MOE_ALIGN
#define MOE_ALIGN true
#endif
#ifndef MOE_SP2
#define MOE_SP2 true
#endif
constexpr int PH_PER_LAYER = 14, N_PHASES = 1 + 2 * PH_PER_LAYER;
#ifndef PHMASK
#define PHMASK 0xFFFFF
#endif
#ifndef REP_MASK
#define REP_MASK 0
#endif
#define REPS(j) ((((REP_MASK) >> (j)) & 1) ? 2 : 1)
#define EN(j) (ONLY < 0 ? (((PHMASK) >> (j)) & 1) : (ONLY == (j)))
template <int ONLY> __global__ void __launch_bounds__(NTHR, 2) mk_fwd(Args args) {
    extern __shared__ __attribute__((aligned(16))) unsigned char lds_raw[];
    Frame F; F.lds = (LAS unsigned char*)lds_raw; F.tid = threadIdx.x; F.lane = F.tid & 63; const int wave0 = __builtin_amdgcn_readfirstlane(F.tid >> 6); F.wave = wave0; F.G = gridDim.x; F.ws = args.ws; F.ka = nullptr;
    volatile LAS unsigned* MISC = (volatile LAS unsigned*)(F.lds + MISC_OFF);
    if (F.tid < 16) MISC[F.tid] = 0u;
    __syncthreads();
    unsigned* ctl = (unsigned*)(F.ws + WS_CTL);
    const int lo = args.ph_lo, hi = args.ph_hi; const bool multi = (hi - lo) > 1;
    XcdBarrier bar; bar.bar = ctl + CW_BAR; bar.x = 0; bar.st = MISC + 8;
    if (multi) bar = xcd_barrier_post(ctl + CW_BAR, MISC + 8);
#define IN(k) (lo <= (k) && (k) < hi)
#ifndef SEAM_REP
#define SEAM_REP 1
#endif
#define SEAM(k) do { if (IN(k) && IN((k) + 1)) for (int sr_ = 0; sr_ < SEAM_REP; ++sr_) xcd_barrier(bar); } while (0)
#define REFRESH() do { int l_; asm volatile("v_mbcnt_lo_u32_b32 %0, -1, 0\n\tv_mbcnt_hi_u32_b32 %0, -1, %0" : "=v"(l_)); F.lane = l_; F.wave = wave0; F.tid = wave0 * 64 + l_; \
    const char __attribute__((address_space(4)))* k_ = (const char __attribute__((address_space(4)))*)__builtin_amdgcn_kernarg_segment_ptr(); asm volatile("" : "+s"(k_)); F.ka = k_; F.ws = *(unsigned char* const __attribute__((address_space(4)))*)(k_ + 184); } while (0)
#define AOUT (*(float* const __attribute__((address_space(4)))*)(F.ka + 176))
#define WSB (F.ws)
#define MOD ((float*)(WSB + WS_MOD))
#define Hb ((bf16*)(WSB + WS_H))
#define ZF ((float*)(WSB + WS_ZF))
#define ZB ((bf16*)(WSB + WS_ZB))
#define CQN ((bf16*)(WSB + WS_CQN))
#define CKVN ((bf16*)(WSB + WS_CKVN))
#define KIDX ((bf16*)(WSB + WS_KIDX))
#define QLAT ((bf16*)(WSB + WS_QLAT))
#define QIDX ((bf16*)(WSB + WS_QIDX))
#define AO ((bf16*)(WSB + WS_AO))
#define AO2 ((bf16*)(WSB + WS_AO2))
#define X1 ((float*)(WSB + WS_X1))
#define X2 ((float*)(WSB + WS_X2))
#define GA ((float*)(WSB + WS_GATE + GATE_GA))
#define GMX ((float*)(WSB + WS_GATE + GATE_GMX))
#define GB ((float*)(WSB + WS_GATE + GATE_GB))
#define MINS ((float*)(WSB + WS_GATE + GATE_MINS))
#define CT ((bf16*)(WSB + WS_CT))
#define NS ((float*)(WSB + WS_NS))
#define XS ((bf16*)(WSB + WS_XS))
#define ACT ((bf16*)(WSB + WS_ACT))
#define YS ((bf16*)(WSB + WS_YS))
#define EIDX ((int*)(WSB + WS_RT + RT_EIDX))
#define GATE ((float*)(WSB + WS_RT + RT_GATE))
#define RANK ((int*)(WSB + WS_RT + RT_RANK))
#define TOKPOS ((int*)(WSB + WS_RT + RT_TOKPOS))
#define ROWGATE ((float*)(WSB + WS_RT + RT_ROWGATE))
#define TILEE ((int*)(WSB + WS_RT + RT_TILEE))
#define NTp ((int*)(WSB + WS_RT + RT_NT))
#define IDXL ((unsigned short*)(WSB + WS_IDXL))
#define ECNT(l) ((int*)(WSB + WS_CTL) + CW_ECNT + (l) * 32)

    if (EN(14) && IN(0)) for (int rep = 0; rep < REPS(14); ++rep) { REFRESH(); p0_prologue(F); }
    SEAM(0);
    for (int l = 0; l < 2; ++l) {
        const int pb = 1 + l * PH_PER_LAYER;
#define mod (MOD + (size_t)l * 4 * 12288)
        if (EN(0) && IN(pb + 0)) for (int rep = 0; rep < REPS(0); ++rep) { REFRESH(); if (l == 0) norm_phase(F, AIN(0), AIN(4), mod + 2048, mod, Hb); }
        if (l == 0) SEAM(pb + 0);
        if (EN(1) && IN(pb + 1)) for (int rep = 0; rep < REPS(1); ++rep) { REFRESH(); pg8::Gemm gm{Hb, (const bf16*)(WSB + WS_WIN) + (size_t)l * NZ * D, T, NZ, D}; pg8::StaticOrder S; S.init(T, NZ, F.G, (int)blockIdx.x);
            EpiZ E{ZF, ZB}; pg8::gemm_phase<EpiZ, pg8::StaticOrder, true, true>(F.lds, gm, S, E, F.wave); }
        SEAM(pb + 1);
        if (EN(2) && IN(pb + 2)) for (int rep = 0; rep < REPS(2); ++rep) { REFRESH(); p3_phase(F, ZF, AIN(6) + l * 512, AIN(7) + l * 256, AIN(12) + l * 4, AIN(13) + l * 4, CQN, CKVN, KIDX, GA, GMX, GB, MINS); }
        SEAM(pb + 2);
        if (EN(3) && IN(pb + 3)) for (int rep = 0; rep < REPS(3); ++rep) { REFRESH(); pg8::Gemm gm{CQN, (const bf16*)(WSB + WS_WQ) + (size_t)l * 2560 * 512, T, 2560, 512}; pg8::StaticOrder S; S.init(T, 2560, F.G, (int)blockIdx.x);
            EpiQ E{QLAT, QIDX}; pg8::gemm_phase<EpiQ, pg8::StaticOrder, true, true>(F.lds, gm, S, E, F.wave); }
        SEAM(pb + 3);
        if (EN(4) && IN(pb + 4)) for (int rep = 0; rep < REPS(4); ++rep) { REFRESH(); m1_scan(F, ZB, GA, GMX, MINS, CT, NS); }
        SEAM(pb + 4);
        if (IN(pb + 5)) {
            if (EN(5)) for (int rep = 0; rep < REPS(5); ++rep) { REFRESH(); dsa_select_phase(F, QIDX, KIDX, ZF, IDXL); }
            if (EN(15)) for (int rep = 0; rep < REPS(15); ++rep) { REFRESH(); m3_out(F, ZB, GA, GMX, GB, MINS, CT, NS, AIN(14) + l * 1024, AO2); } }
        SEAM(pb + 5);
        if (EN(6) && IN(pb + 6)) for (int rep = 0; rep < REPS(6); ++rep) { REFRESH(); dsa_attn_phase(F, IDXL, QLAT, CKVN, AO, (const bf16*)(WSB + WS_WUVT) + (size_t)l * 8 * 128 * 256, AO2); }
        SEAM(pb + 6);
        if (EN(7) && IN(pb + 7)) for (int rep = 0; rep < REPS(7); ++rep) { REFRESH(); pg8::Gemm gm{AO2, (const bf16*)(WSB + WS_WOUT) + (size_t)l * 2048 * 2048, T, 2048, 2048}; pg8::StaticOrder S; S.init(T, 2048, F.G, (int)blockIdx.x);
            EpiRes E{(l == 0) ? AIN(0) : (const float*)X2, X1, mod + 2 * 2048}; pg8::gemm_phase<EpiRes, pg8::StaticOrder, true, true>(F.lds, gm, S, E, F.wave); }
        SEAM(pb + 7);
        if (EN(8) && IN(pb + 8)) for (int rep = 0; rep < REPS(8); ++rep) { REFRESH(); norm_phase(F, X1, AIN(16) + l * 2048, mod + 4 * 2048, mod + 3 * 2048, Hb); }
        if (F.G != 256) SEAM(pb + 8);
        if (EN(9) && IN(pb + 9)) { REFRESH(); router_phase(F, Hb, (const bf16*)(WSB + WS_WR), AIN(18), ECNT(l), EIDX, GATE, RANK); }
        SEAM(pb + 9);
        if (EN(10) && IN(pb + 10)) for (int rep = 0; rep < REPS(10); ++rep) { REFRESH(); scatter_phase(F, Hb, ECNT(l), EIDX, GATE, RANK, XS, TOKPOS, ROWGATE, TILEE, NTp); }
        SEAM(pb + 10);
        if (EN(11) && IN(pb + 11)) for (int rep = 0; rep < REPS(11); ++rep) { REFRESH(); pg8::Gemm gm{XS, (const bf16*)(WSB + WS_WGU) + (size_t)l * 32 * 1024 * 2048, MPAD, 32 * 1024, 2048}; MoeOrder<4> S{TILEE, NTp[0], F.G, (int)blockIdx.x};
            EpiGU E{ACT}; pg8::gemm_phase<EpiGU, MoeOrder<4>, MOE_ALIGN, MOE_SP2>(F.lds, gm, S, E, F.wave); }
        SEAM(pb + 11);
        if (EN(12) && IN(pb + 12)) for (int rep = 0; rep < REPS(12); ++rep) { REFRESH(); pg8::Gemm gm{ACT, (const bf16*)(WSB + WS_WD) + (size_t)l * 32 * 2048 * 512, MPAD, 32 * 2048, 512}; MoeOrder<8> S{TILEE, NTp[0], F.G, (int)blockIdx.x};
            EpiDN E{YS, ROWGATE}; pg8::gemm_phase<EpiDN, MoeOrder<8>, MOE_ALIGN, MOE_SP2>(F.lds, gm, S, E, F.wave); }
        SEAM(pb + 12);
        if (EN(13) && IN(pb + 13)) for (int rep = 0; rep < REPS(13); ++rep) { REFRESH(); const float* mod1 = MOD + (size_t)4 * 12288;
            if (l == 0) combine_phase(F, 0, X1, mod + 5 * 2048, YS, TOKPOS, X2, AIN(4) + 2048, mod1 + 2048, mod1, Hb, nullptr);
            else combine_phase(F, 1, X1, mod + 5 * 2048, YS, TOKPOS, nullptr, AIN(21), nullptr, nullptr, nullptr, AOUT); }
        SEAM(pb + 13);
    }
#undef IN
#undef SEAM
}

#ifndef MK_N_LAUNCHES
#define MK_N_LAUNCHES 1
#endif
extern "C" void kernel_launch(void* const* d_in, const int* in_sizes, int n_in, void* d_out, int out_size, void* d_ws, size_t ws_size, hipStream_t stream) {
    static int grid = 0;
    if (grid == 0) {
        if (n_in != 22 || out_size != T * D || ws_size < WS_END) { fprintf(stderr, "kernel_launch: unexpected problem (n_in %d out %d ws %zu)\n", n_in, out_size, ws_size); grid = -1; return; }
        int dev = 0, cus = 0, per_cu = 0;
        if (hipGetDevice(&dev) != hipSuccess || hipDeviceGetAttribute(&cus, hipDeviceAttributeMultiprocessorCount, dev) != hipSuccess) { grid = -1; return; }
        bool ok = true;
#define SETATTR(K) ok = ok && (hipFuncSetAttribute((const void*)mk_fwd<K>, hipFuncAttributeMaxDynamicSharedMemorySize, LDS_BYTES) == hipSuccess)
#if MK_N_LAUNCHES == 1
        SETATTR(-1);
#else
        SETATTR(14); SETATTR(15); SETATTR(0); SETATTR(1); SETATTR(2); SETATTR(3); SETATTR(4); SETATTR(5); SETATTR(6); SETATTR(7); SETATTR(8); SETATTR(9); SETATTR(10); SETATTR(11); SETATTR(12); SETATTR(13);
#endif
#undef SETATTR
        if (!ok) { fprintf(stderr, "kernel_launch: hipFuncSetAttribute failed\n"); grid = -1; return; }
        if (hipOccupancyMaxActiveBlocksPerMultiprocessor(&per_cu, (const void*)mk_fwd<(MK_N_LAUNCHES == 1 ? -1 : 1)>, NTHR, LDS_BYTES) != hipSuccess || per_cu < 1) fprintf(stderr, "kernel_launch: occupancy query says %d\n", per_cu);
        (void)hipGetLastError();
        grid = cus;
    }
    if (grid < 0) return;
    (void)hipMemsetAsync((char*)d_ws + WS_CTL, 0, CTL_ZERO_BYTES, stream);
    Args a{};
    for (int i = 0; i < 22; ++i) a.in[i] = (const float*)d_in[i];
    a.out = (float*)d_out; a.ws = (unsigned char*)d_ws;
#if MK_N_LAUNCHES == 1
    { a.ph_lo = 0; a.ph_hi = N_PHASES; hipLaunchKernelGGL(mk_fwd<-1>, dim3(grid), dim3(NTHR), LDS_BYTES, stream, a); }
#else
    {
        for (int p = 0; p < N_PHASES; ++p) {
            if (p == 1 + PH_PER_LAYER) continue;
            a.ph_lo = p; a.ph_hi = p + 1;
            const int j = (p == 0) ? 14 : (p - 1) % PH_PER_LAYER;
#define LCASE(K) case K: hipLaunchKernelGGL(mk_fwd<K>, dim3(grid), dim3(NTHR), LDS_BYTES, stream, a); break
            if (j == 5) hipLaunchKernelGGL(mk_fwd<15>, dim3(grid), dim3(NTHR), LDS_BYTES, stream, a);
            switch (j) { LCASE(0); LCASE(1); LCASE(2); LCASE(3); LCASE(4); LCASE(5); LCASE(6); LCASE(7); LCASE(8); LCASE(9); LCASE(10); LCASE(11); LCASE(12); LCASE(13); LCASE(14); }
#undef LCASE
        }
    }
#endif
}
```
